# Optimizing an MI355X kernel written in HIP

```python
import math
import jax, jax.numpy as jnp
from jax import lax
import numpy as np

D_MODEL = 2048
BATCH = 1
SEQ = 16384
DEPTH = 2

CHUNK = 64
Q_BLOCK = 128
HEAD_DIM = 128
N_HEADS_A = 6
N_HEADS_B = 6
N_HEADS_C = 4
WIDTH_A = N_HEADS_A * HEAD_DIM
WIDTH_B = N_HEADS_B * HEAD_DIM
WIDTH_C = N_HEADS_C * HEAD_DIM
DIFF_DIM = HEAD_DIM // 2
LEFT_CHUNKS = 8
BAND_CHUNKS = LEFT_CHUNKS + 1
REL_CLIP = 256
ROPE_THETA = 500000.0
ROPE_DIM = DIFF_DIM // 4
D_FF = 7168
N_EXPERTS = 8
TOP_K = 2
N_DENSE = (DEPTH + 1) // 2
N_MOE = DEPTH // 2
EPS = 1e-6
NEG_INF = -1e30
IN_WIDTHS = (WIDTH_A, WIDTH_A, WIDTH_A, N_HEADS_A,
             WIDTH_B, WIDTH_B, WIDTH_B,
             WIDTH_C, WIDTH_C, WIDTH_C)
D_IN = 3 * (WIDTH_A + WIDTH_B + WIDTH_C) + N_HEADS_A

kernel_name = "hybrid_fox_chunkband_diffattn_sandwich_adaln_moe"


def rms_norm(x, g):
    xf = x.astype(jnp.float32)
    y = xf * lax.rsqrt(jnp.mean(xf * xf, axis=-1, keepdims=True) + EPS)
    return (y * g.astype(jnp.float32)).astype(x.dtype)


def partial_rope(x, positions):
    half = ROPE_DIM // 2
    inv = ROPE_THETA ** (-(jnp.arange(half, dtype=jnp.float32) * 2.0 / ROPE_DIM))
    ang = positions.astype(jnp.float32)[..., None] * inv
    cos = jnp.cos(ang)[:, :, None, None, :]
    sin = jnp.sin(ang)[:, :, None, None, :]
    xr = x[..., :ROPE_DIM].astype(jnp.float32)
    x1, x2 = xr[..., :half], xr[..., half:]
    rot = jnp.concatenate([x1 * cos - x2 * sin, x2 * cos + x1 * sin], axis=-1)
    return jnp.concatenate([rot.astype(x.dtype), x[..., ROPE_DIM:]], axis=-1)


def forgetting_attention(q, k, v, log_f):
    B, S, H, d = q.shape
    nb = S // Q_BLOCK
    F = jnp.cumsum(log_f, axis=1)
    Ft = F.transpose(0, 2, 1)
    qb = q.reshape(B, nb, Q_BLOCK, H, d).transpose(1, 0, 2, 3, 4)
    Fb = F.reshape(B, nb, Q_BLOCK, H).transpose(1, 0, 3, 2)
    kpos = jnp.arange(S)
    scale = d ** -0.5

    def block(args):
        qi, Fi, i = args
        s = jnp.einsum('bqhd,bkhd->bhqk', qi, k, preferred_element_type=jnp.float32) * scale
        s = s + Fi[..., None] - Ft[:, :, None, :]
        qpos = i * Q_BLOCK + jnp.arange(Q_BLOCK)
        s = jnp.where(kpos[None, :] <= qpos[:, None], s, NEG_INF)
        p = jax.nn.softmax(s, axis=-1)
        return jnp.einsum('bhqk,bkhd->bqhd', p.astype(v.dtype), v)

    out = lax.map(block, (qb, Fb, jnp.arange(nb)))
    return out.transpose(1, 0, 2, 3, 4).reshape(B, S, H, d)


def chunk_band_attention(q, k, v, rel_bias):
    B, S, H, d = q.shape
    nc = S // CHUNK
    band = BAND_CHUNKS * CHUNK
    pad = ((0, 0), (LEFT_CHUNKS * CHUNK, 0), (0, 0), (0, 0))
    kp = jnp.pad(k, pad).reshape(B, nc + LEFT_CHUNKS, CHUNK, H, d)
    vp = jnp.pad(v, pad).reshape(B, nc + LEFT_CHUNKS, CHUNK, H, d)
    k_band = jnp.concatenate([kp[:, j:j + nc] for j in range(BAND_CHUNKS)], axis=2)
    v_band = jnp.concatenate([vp[:, j:j + nc] for j in range(BAND_CHUNKS)], axis=2)
    qc = q.reshape(B, nc, CHUNK, H, d)
    s = jnp.einsum('bnqhd,bnkhd->bnhqk', qc, k_band, preferred_element_type=jnp.float32) * (d ** -0.5)
    s_rel = jnp.arange(band) - LEFT_CHUNKS * CHUNK
    dist = jnp.arange(CHUNK)[:, None] - s_rel[None, :]
    idx = jnp.clip(dist, -REL_CLIP, REL_CLIP) + REL_CLIP
    s = s + rel_bias[:, idx].astype(jnp.float32)
    valid = (jnp.arange(nc)[:, None] * CHUNK + s_rel[None, :]) >= 0
    s = jnp.where(valid[None, :, None, None, :], s, NEG_INF)
    p = jax.nn.softmax(s, axis=-1)
    o = jnp.einsum('bnhqk,bnkhd->bnqhd', p.astype(v.dtype), v_band)
    return o.reshape(B, S, H, d)


def diff_attention(q, k, v, lam):
    B, S, H, _, dd = q.shape
    nb = S // Q_BLOCK
    qb = q.reshape(B, nb, Q_BLOCK, H, 2, dd).transpose(1, 0, 2, 3, 4, 5)
    kchunk = jnp.arange(S) // CHUNK
    scale = dd ** -0.5

    def block(args):
        qi, i = args
        s = jnp.einsum('bqhnd,bkhnd->bnhqk', qi, k, preferred_element_type=jnp.float32) * scale
        qchunk = (i * Q_BLOCK + jnp.arange(Q_BLOCK)) // CHUNK
        s = jnp.where(kchunk[None, :] <= qchunk[:, None], s, NEG_INF)
        p = jax.nn.softmax(s, axis=-1)
        w = p[:, 0] - lam * p[:, 1]
        return jnp.einsum('bhqk,bkhd->bqhd', w.astype(v.dtype), v)

    out = lax.map(block, (qb, jnp.arange(nb)))
    return out.transpose(1, 0, 2, 3, 4).reshape(B, S, H, v.shape[-1])


def hybrid_mixer(h, positions, w_in, b_f, rel_bias, lam, onorm, w_o, layer_idx):
    B, S, _ = h.shape
    proj = jnp.einsum('bsd,de->bse', h, w_in)
    split_pts = np.cumsum(np.array(IN_WIDTHS))[:-1].tolist()
    qa, ka, va, fa, qb, kb, vb, qc, kc, vc = jnp.split(proj, split_pts, axis=-1)
    heads = lambda t, n: t.reshape(B, S, n, HEAD_DIM)
    log_f = jax.nn.log_sigmoid(fa.astype(jnp.float32) + b_f.astype(jnp.float32))
    o_a = forgetting_attention(heads(qa, N_HEADS_A), heads(ka, N_HEADS_A), heads(va, N_HEADS_A), log_f)
    o_b = chunk_band_attention(heads(qb, N_HEADS_B), heads(kb, N_HEADS_B), heads(vb, N_HEADS_B), rel_bias)
    qc = partial_rope(qc.reshape(B, S, N_HEADS_C, 2, DIFF_DIM), positions)
    kc = partial_rope(kc.reshape(B, S, N_HEADS_C, 2, DIFF_DIM), positions)
    lam_init = 0.8 - 0.6 * math.exp(-0.3 * layer_idx)
    lf = lam.astype(jnp.float32)
    lam_full = jnp.exp(jnp.sum(lf[0] * lf[1])) - jnp.exp(jnp.sum(lf[2] * lf[3])) + lam_init
    o_c = diff_attention(qc, kc, heads(vc, N_HEADS_C), lam_full)
    o = jnp.concatenate([rms_norm(o_a, onorm[0]),
                         rms_norm(o_b, onorm[1]),
                         rms_norm(o_c, onorm[2]) * (1.0 - lam_init)], axis=2)
    return jnp.einsum('bse,ed->bsd', o.reshape(B, S, -1), w_o)


def swiglu(h, wg, wu, wd):
    a = jnp.einsum('bsd,df->bsf', h, wg)
    u = jnp.einsum('bsd,df->bsf', h, wu)
    return jnp.einsum('bsf,fd->bsd', jax.nn.silu(a) * u, wd)


def moe_ffn(h, router_w, router_b, wg, wu, wd):
    logits = jnp.einsum('bsd,de->bse', h, router_w).astype(jnp.float32) + router_b.astype(jnp.float32)
    top_v, top_i = lax.top_k(logits, TOP_K)
    gates = jax.nn.softmax(top_v, axis=-1)
    combine = jnp.sum(jax.nn.one_hot(top_i, N_EXPERTS, dtype=jnp.float32) * gates[..., None], axis=-2)
    out = jnp.zeros(h.shape, jnp.float32)
    for e in range(N_EXPERTS):
        out = out + combine[..., e:e + 1] * swiglu(h, wg[e], wu[e], wd[e]).astype(jnp.float32)
    return out.astype(h.dtype)


def setup_inputs(seed: int = 0) -> dict:
    key = jax.random.key(seed)
    ks = jax.random.split(key, 21)
    f32 = jnp.float32
    D = D_MODEL
    nrm = lambda k, shape, scale: jax.random.normal(k, shape, f32) * scale
    x = nrm(ks[0], (BATCH, SEQ, D), 1.0)
    c = nrm(ks[1], (BATCH, D), 1.0)
    offset = jax.random.randint(ks[2], (BATCH, 1), 0, 1024, dtype=jnp.int32) * CHUNK
    positions = offset + jnp.arange(SEQ, dtype=jnp.int32)[None, :]
    return {
        "x": x,
        "c": c,
        "positions": positions,
        "mod_w": nrm(ks[3], (DEPTH, D, 6 * D), 0.5 * D ** -0.5),
        "mod_b": nrm(ks[4], (DEPTH, 6 * D), 0.02),
        "norm_g": 1.0 + nrm(ks[5], (DEPTH, 4, D), 0.02),
        "w_in": nrm(ks[6], (DEPTH, D, D_IN), D ** -0.5),
        "b_f": nrm(ks[7], (DEPTH, N_HEADS_A), 0.5),
        "rel_bias": nrm(ks[8], (DEPTH, N_HEADS_B, 2 * REL_CLIP + 1), 0.5),
        "lam": nrm(ks[9], (DEPTH, 4, DIFF_DIM), 0.1),
        "onorm": 1.0 + nrm(ks[10], (DEPTH, 3, HEAD_DIM), 0.02),
        "w_o": nrm(ks[11], (DEPTH, D, D), D ** -0.5),
        "ffn_wg": nrm(ks[12], (N_DENSE, D, D_FF), D ** -0.5),
        "ffn_wu": nrm(ks[13], (N_DENSE, D, D_FF), D ** -0.5),
        "ffn_wd": nrm(ks[14], (N_DENSE, D_FF, D), D_FF ** -0.5),
        "router_w": nrm(ks[15], (N_MOE, D, N_EXPERTS), D ** -0.5),
        "router_b": nrm(ks[16], (N_MOE, N_EXPERTS), 0.01),
        "exp_wg": nrm(ks[17], (N_MOE, N_EXPERTS, D, D_FF), D ** -0.5),
        "exp_wu": nrm(ks[18], (N_MOE, N_EXPERTS, D, D_FF), D ** -0.5),
        "exp_wd": nrm(ks[19], (N_MOE, N_EXPERTS, D_FF, D), D_FF ** -0.5),
    }


def reference(x, c, positions, mod_w, mod_b, norm_g, w_in, b_f, rel_bias, lam, onorm, w_o,
              ffn_wg, ffn_wu, ffn_wd, router_w, router_b, exp_wg, exp_wu, exp_wd):
    cond = jax.nn.silu(c)
    for l in range(DEPTH):
        mod = (jnp.einsum('bd,de->be', cond, mod_w[l]) + mod_b[l])[:, None, :]
        sh_m, sc_m, g_m, sh_f, sc_f, g_f = jnp.split(mod, 6, axis=-1)
        h = rms_norm(x, norm_g[l, 0]) * (1.0 + sc_m) + sh_m
        y = hybrid_mixer(h, positions, w_in[l], b_f[l], rel_bias[l], lam[l], onorm[l], w_o[l], l)
        x = x + g_m * rms_norm(y, norm_g[l, 1])
        h = rms_norm(x, norm_g[l, 2]) * (1.0 + sc_f) + sh_f
        i = l // 2
        if l % 2 == 0:
            y = swiglu(h, ffn_wg[i], ffn_wu[i], ffn_wd[i])
        else:
            y = moe_ffn(h, router_w[i], router_b[i], exp_wg[i], exp_wu[i], exp_wd[i])
        x = x + g_f * rms_norm(y, norm_g[l, 3])
    return x
```

```cpp
#include <hip/hip_runtime.h>
#include <cstdio>
#include <cstdint>

#ifndef MK_PER_PHASE
#define MK_PER_PHASE 0
#endif

#ifndef MK_DUP
#define MK_DUP 0
#endif
#ifndef MK_DENSE_FP8
#define MK_DENSE_FP8 0
#endif
#ifndef MK_DENSE_DN8
#define MK_DENSE_DN8 1
#endif
#ifndef MK_WT
#define MK_WT 0
#endif
#ifndef MK_ALIGN8
#define MK_ALIGN8 false
#endif
#ifndef MK_NAIVE_ATTN
#define MK_NAIVE_ATTN 0
#endif
#ifndef MK_PV8
#define MK_PV8 1
#endif
#ifndef MK_QK8
#define MK_QK8 1
#endif
#ifndef MK_LS8
#define MK_LS8 1
#endif
#ifndef MK_STEPF
#define MK_STEPF 1
#endif
#ifndef MK_CMB
#define MK_CMB 1
#endif
#ifndef MK_QK8AB
#define MK_QK8AB 1
#endif
#ifndef MK_XCONV
#define MK_XCONV 1
#endif
#ifndef MK_KHALF
#define MK_KHALF 1
#endif
#define LAS __attribute__((address_space(3)))
#define GAS __attribute__((address_space(1)))
typedef unsigned short bf16_t;
typedef short bf16x8 __attribute__((ext_vector_type(8)));
typedef float f32x4 __attribute__((ext_vector_type(4)));
typedef float f32x2 __attribute__((ext_vector_type(2)));
typedef unsigned u32x4 __attribute__((ext_vector_type(4)));
typedef unsigned u32x2 __attribute__((ext_vector_type(2)));
typedef int i32x8 __attribute__((ext_vector_type(8)));
typedef int i32x4 __attribute__((ext_vector_type(4)));

constexpr int S = 16384, D = 2048, DFF = 7168, NE = 8, NPROJ = 6144, DIN = 6150;
constexpr int NHA = 6, NHB = 6, NHC = 4, HD = 128;
constexpr int QA = 0, KA = 768, VA = 1536, QB_ = 2304, KB_ = 3072, VB_ = 3840, QC = 4608, KC = 5120, VC = 5632;
constexpr float EPS = 1e-6f;
constexpr float LOG2E = 1.4426950408889634f;
constexpr float SCALE_A = 0.08838834764831845f * LOG2E;
constexpr float SCALE_C = 0.125f * LOG2E;
constexpr int MAXTILES = 136, MAXSLOTS = MAXTILES * 256;
constexpr int NMODP = 16;
constexpr float SH8 = 4.f, SW8 = 32.f, SA8 = 8.f, SWD8 = 64.f;

constexpr size_t MiB = 1u << 20;
constexpr size_t WS_CTL = 0, CTL_ZERO_BYTES = 64 * 1024;
constexpr size_t WS_MODP = 1 * MiB;
constexpr size_t WS_ROPE = 3 * MiB;
constexpr size_t WS_LOGF = 4 * MiB;
constexpr size_t WS_FREL = 5 * MiB;
constexpr size_t WS_FBASE = 5 * MiB + 512 * 1024;
constexpr size_t WS_QN = 5 * MiB + 640 * 1024;
constexpr size_t WS_KN = 5 * MiB + 704 * 1024;
constexpr size_t WS_TOKE = 6 * MiB;
constexpr size_t WS_TOKG = 6 * MiB + 256 * 1024;
constexpr size_t WS_TOKS = 6 * MiB + 512 * 1024;
constexpr size_t WS_TILES = 6 * MiB + 768 * 1024;
constexpr size_t WS_FD = 7 * MiB;
constexpr size_t WS_WIN = 16 * MiB;
constexpr size_t WS_WO = 64 * MiB;
constexpr size_t WS_WGU = 80 * MiB;
constexpr size_t WS_WD = 136 * MiB;
constexpr size_t WS_EGU = 164 * MiB;
constexpr size_t WS_XB = 400 * MiB;
constexpr size_t WS_YPS = 464 * MiB;
constexpr size_t WS_ED = 612 * MiB;
constexpr size_t WS_H = 836 * MiB;
constexpr size_t WS_Y = 900 * MiB;
constexpr size_t WS_CST = WS_Y;
constexpr size_t WS_VT8 = 964 * MiB;
constexpr size_t WS_Q8 = 972 * MiB, WS_K8 = 980 * MiB;
constexpr size_t WS_BIG = 996 * MiB;
constexpr size_t WS_PROJ = WS_BIG;
constexpr size_t WS_O = WS_BIG + 192 * MiB;
constexpr size_t WS_ACT = WS_BIG;
constexpr size_t WS_HS = WS_BIG;
constexpr size_t WS_ACTS = WS_BIG + 136 * MiB;
constexpr size_t WS_YP = WS_BIG + 612 * MiB;
constexpr size_t WS_Q8AB = WS_BIG + 748 * MiB, WS_K8AB = WS_BIG + 772 * MiB;
constexpr size_t WS_END = WS_BIG + 796 * MiB;
constexpr int CW_TMO = 0, CW_CODE = 1;
constexpr int CW_BAR = 4096;
constexpr int CW_CMB = 8192;

constexpr int RING_BYTES = 135168;
constexpr int MISC_OFF = RING_BYTES;
constexpr int LDS_BYTES = 147456;

__device__ __forceinline__ unsigned cvt_pk_bf16(float lo, float hi) { unsigned r; asm("v_cvt_pk_bf16_f32 %0, %1, %2" : "=v"(r) : "v"(lo), "v"(hi)); return r; }
__device__ __forceinline__ unsigned pk4_fp8(float a, float b, float c, float d) {
    a = __builtin_amdgcn_fmed3f(a, -448.f, 448.f); b = __builtin_amdgcn_fmed3f(b, -448.f, 448.f); c = __builtin_amdgcn_fmed3f(c, -448.f, 448.f); d = __builtin_amdgcn_fmed3f(d, -448.f, 448.f);
    int w = 0; w = __builtin_amdgcn_cvt_pk_fp8_f32(a, b, w, false); w = __builtin_amdgcn_cvt_pk_fp8_f32(c, d, w, true); return (unsigned)w; }
__device__ __forceinline__ void st16(void* p, u32x4 v) {
#if MK_WT
    asm volatile("global_store_dwordx4 %0, %1, off sc0 sc1" :: "v"(p), "v"(v) : "memory");
#else
    *(u32x4*)p = v;
#endif
}
__device__ __forceinline__ void st8(void* p, u32x2 v) {
#if MK_WT
    asm volatile("global_store_dwordx2 %0, %1, off sc0 sc1" :: "v"(p), "v"(v) : "memory");
#else
    *(u32x2*)p = v;
#endif
}
__device__ __forceinline__ float bf_lo(unsigned w) { return __uint_as_float(w << 16); }
__device__ __forceinline__ float bf_hi(unsigned w) { return __uint_as_float(w & 0xffff0000u); }
template <int M> __device__ __forceinline__ float sxor(float v) { return __int_as_float(__builtin_amdgcn_ds_swizzle(__float_as_int(v), (M << 10) | 0x1f)); }
__device__ __forceinline__ float half_sum(float v) { auto rr = __builtin_amdgcn_permlane32_swap(__float_as_uint(v), __float_as_uint(v), false, false); return __uint_as_float(rr[0]) + __uint_as_float(rr[1]); }
__device__ __forceinline__ float half_max(float v) { auto rr = __builtin_amdgcn_permlane32_swap(__float_as_uint(v), __float_as_uint(v), false, false); return fmaxf(__uint_as_float(rr[0]), __uint_as_float(rr[1])); }
__device__ __forceinline__ float wave_sum(float v) { v += sxor<1>(v); v += sxor<2>(v); v += sxor<4>(v); v += sxor<8>(v); v += sxor<16>(v); return half_sum(v); }
__device__ __forceinline__ float wave_max(float v) { v = fmaxf(v, sxor<1>(v)); v = fmaxf(v, sxor<2>(v)); v = fmaxf(v, sxor<4>(v)); v = fmaxf(v, sxor<8>(v)); v = fmaxf(v, sxor<16>(v)); return half_max(v); }
__device__ __forceinline__ int opq(int i) { asm volatile("" : "+s"(i)); return i; }
__device__ __forceinline__ int lane_now() { int t; asm volatile("v_mbcnt_lo_u32_b32 %0, -1, 0\n\tv_mbcnt_hi_u32_b32 %0, -1, %0" : "=v"(t)); return t; }
__device__ __forceinline__ int launder_tid(int wave) { return wave * 64 + lane_now(); }
#define LDS_WAIT() asm volatile("s_waitcnt lgkmcnt(0)" ::: "memory")
#define VM_WAIT() asm volatile("s_waitcnt vmcnt(0)" ::: "memory")

namespace pg8 {
constexpr int BM = 256, BK = 64, HALF = 128, HTB = HALF * BK * 2, STAGE_BYTES = 8 * HTB, NXCD = 8, WGM = 4;
__host__ __device__ __forceinline__ int lds_byte(int r, int c) { const int st = (r >> 4) * 2 + (c >> 5), rr = r & 15, cc = c & 31, ob = rr * 64 + cc * 2; return st * 1024 + (ob ^ (((ob >> 9) & 1) << 5)); }
__host__ __device__ __forceinline__ void stage_rc(int b, int& R, int& C) { const int st = b / 1024, sb = b % 1024, swz = sb ^ (((sb >> 9) & 1) << 5); R = (st >> 1) * 16 + swz / 64; C = (st & 1) * 32 + (swz % 64) / 2; }
__host__ __device__ __forceinline__ void stage_rc8(int b, int& R, int& C) { const int p = b >> 4, g = p >> 7, h = (p >> 6) & 1, fq = (p >> 4) & 3, rr = p & 15; R = 16 * g + rr; C = 8 * (2 * fq + h); }
__host__ __device__ __forceinline__ int perm32(int rho) { const int n = rho >> 4, i = rho & 15; return 8 * (i >> 2) + 4 * n + (i & 3); }

struct Unit { int pm, pn, e, ks; };
struct Gemm { const bf16_t* A; const bf16_t* Bt; size_t bstride; };

template <int NN, int NMC>
struct StaticOrder {
    int nMr, G, c; const int* texp;
    __device__ void init(int nM_, int G_, int c_, const int* texp_) { nMr = nM_; G = G_; c = c_; texp = texp_; }
    __device__ bool next(int i, Unit& u) const {
        const int nM = NMC ? NMC : nMr, nN = NN, nwg = nM * nN;
        const long L = (long)i * G + c; if (L >= nwg) return false;
        int wgid = (int)L; { const int q = nwg / NXCD, r = nwg % NXCD, xcd = wgid % NXCD, off = wgid / NXCD; wgid = (xcd < r ? xcd * (q + 1) : r * (q + 1) + (xcd - r) * q) + off; }
        const int nig = WGM * nN, gid = wgid / nig, fm = gid * WGM, gsz = (nM - fm) < WGM ? (nM - fm) : WGM;
        u.pm = fm + ((wgid % nig) % gsz); u.pn = (wgid % nig) / gsz; u.e = texp ? __builtin_amdgcn_readfirstlane(texp[u.pm]) : 0; u.ks = 0; return true;
    }
};
struct SplitOrder {
    int rt, c; const int* texp;
    __device__ void init(int rt_, int c_, const int* texp_) { rt = rt_; c = c_; texp = texp_; }
    __device__ bool next(int i, Unit& u) const { if (i > 0 || c >= 32 * rt) return false; u.pm = 128 + (c >> 5); u.pn = (c >> 2) & 7; u.ks = c & 3; u.e = __builtin_amdgcn_readfirstlane(texp[u.pm]); return true; }
};

struct EpiPlain {
    static constexpr bool PERM = true;
    bf16_t* O; int ldc; float sc;
    __device__ __forceinline__ void operator()(const f32x4 (&acc)[2][2][4][2], const Unit& u, int wr, int wc, int fr, int fq) const {
        const int row0 = u.pm * BM + wr * 64 + fr, col0 = u.pn * BM + wc * 32 + 8 * fq;
#pragma unroll
        for (int ai = 0; ai < 2; ++ai)
#pragma unroll
            for (int m = 0; m < 4; ++m) { bf16_t* rowp = O + (size_t)(row0 + ai * HALF + m * 16) * ldc + col0;
#pragma unroll
                for (int bj = 0; bj < 2; ++bj) { const f32x4 v0 = acc[ai][bj][m][0] * sc, v1 = acc[ai][bj][m][1] * sc;
                    u32x4 w; w.x = cvt_pk_bf16(v0[0], v0[1]); w.y = cvt_pk_bf16(v0[2], v0[3]); w.z = cvt_pk_bf16(v1[0], v1[1]); w.w = cvt_pk_bf16(v1[2], v1[3]);
                    st16(rowp + bj * HALF, w); } }
    }
};
struct EpiPartial {
    static constexpr bool PERM = true;
    float* O; int ldc;
    __device__ __forceinline__ void operator()(const f32x4 (&acc)[2][2][4][2], const Unit& u, int wr, int wc, int fr, int fq) const {
        const int row0 = (u.ks * 8 + (u.pm - 128)) * BM + wr * 64 + fr, col0 = u.pn * BM + wc * 32 + 8 * fq;
#pragma unroll
        for (int ai = 0; ai < 2; ++ai)
#pragma unroll
            for (int m = 0; m < 4; ++m) { float* rowp = O + (size_t)(row0 + ai * HALF + m * 16) * ldc + col0;
#pragma unroll
                for (int bj = 0; bj < 2; ++bj) { *(f32x4*)(rowp + bj * HALF) = acc[ai][bj][m][0]; *(f32x4*)(rowp + bj * HALF + 4) = acc[ai][bj][m][1]; } }
    }
};
struct EpiSwiGLU8 {
    static constexpr bool PERM = true;
    unsigned char* O; int ldc;
    __device__ __forceinline__ void operator()(const f32x4 (&acc)[2][2][4][2], const Unit& u, int wr, int wc, int fr, int fq) const {
        const int row0 = u.pm * BM + wr * 64 + fr, col0 = u.pn * HALF + wc * 32 + 8 * fq;
        constexpr float IS = 1.0f / (SH8 * SW8);
#pragma unroll
        for (int ai = 0; ai < 2; ++ai)
#pragma unroll
            for (int m = 0; m < 4; ++m) { unsigned char* rowp = O + (size_t)(row0 + ai * HALF + m * 16) * ldc + col0;
                float r[8];
#pragma unroll
                for (int n = 0; n < 2; ++n)
#pragma unroll
                    for (int q = 0; q < 4; ++q) { const float g = acc[ai][0][m][n][q] * IS, up = acc[ai][1][m][n][q] * (IS * SA8);
                        const float sg = g * __builtin_amdgcn_rcpf(1.0f + __builtin_amdgcn_exp2f(-g * LOG2E)); r[n * 4 + q] = sg * up; }
                u32x2 w; w.x = pk4_fp8(r[0], r[1], r[2], r[3]); w.y = pk4_fp8(r[4], r[5], r[6], r[7]);
                st8(rowp, w); }
    }
};
struct EpiSwiGLU8b {
    static constexpr bool PERM = true;
    unsigned char* O; int ldc;
    __device__ __forceinline__ void operator()(const f32x4 (&acc)[2][2][4][2], const Unit& u, int wr, int wc, int fr, int fq) const {
        const int row0 = u.pm * BM + wr * 64 + fr, col0 = u.pn * HALF + wc * 32 + 8 * fq;
        constexpr float IS = 1.0f;
#pragma unroll
        for (int ai = 0; ai < 2; ++ai)
#pragma unroll
            for (int m = 0; m < 4; ++m) { unsigned char* rowp = O + (size_t)(row0 + ai * HALF + m * 16) * ldc + col0;
                float r[8];
#pragma unroll
                for (int n = 0; n < 2; ++n)
#pragma unroll
                    for (int q = 0; q < 4; ++q) { const float g = acc[ai][0][m][n][q] * IS, up = acc[ai][1][m][n][q] * (IS * SA8);
                        const float sg = g * __builtin_amdgcn_rcpf(1.0f + __builtin_amdgcn_exp2f(-g * LOG2E)); r[n * 4 + q] = sg * up; }
                u32x2 w; w.x = pk4_fp8(r[0], r[1], r[2], r[3]); w.y = pk4_fp8(r[4], r[5], r[6], r[7]);
                st8(rowp, w); }
    }
};
struct EpiSwiGLU {
    static constexpr bool PERM = true;
    bf16_t* O; int ldc;
    __device__ __forceinline__ void operator()(const f32x4 (&acc)[2][2][4][2], const Unit& u, int wr, int wc, int fr, int fq) const {
        const int row0 = u.pm * BM + wr * 64 + fr, col0 = u.pn * HALF + wc * 32 + 8 * fq;
#pragma unroll
        for (int ai = 0; ai < 2; ++ai)
#pragma unroll
            for (int m = 0; m < 4; ++m) { bf16_t* rowp = O + (size_t)(row0 + ai * HALF + m * 16) * ldc + col0;
                float r[8];
#pragma unroll
                for (int n = 0; n < 2; ++n)
#pragma unroll
                    for (int q = 0; q < 4; ++q) { const float g = acc[ai][0][m][n][q], up = acc[ai][1][m][n][q];
                        const float sg = g * __builtin_amdgcn_rcpf(1.0f + __builtin_amdgcn_exp2f(-g * LOG2E)); r[n * 4 + q] = sg * up; }
                u32x4 w; w.x = cvt_pk_bf16(r[0], r[1]); w.y = cvt_pk_bf16(r[2], r[3]); w.z = cvt_pk_bf16(r[4], r[5]); w.w = cvt_pk_bf16(r[6], r[7]);
                st16(rowp, w); }
    }
};
constexpr float fa_SV8 = 16.f;
constexpr float fa_SQ8 = 4.f, fa_SK8 = 0.25f;
struct EpiProj {
    static constexpr bool PERM = true;
    bf16_t* O; const float* rope;
    unsigned char* q8; unsigned char* k8;
    unsigned char* q8ab; unsigned char* k8ab;
    unsigned char* vt8;
    __device__ __forceinline__ void operator()(const f32x4 (&acc)[2][2][4][2], const Unit& u, int wr, int wc, int fr, int fq) const {
        const int row0 = u.pm * BM + wr * 64 + fr, col0 = u.pn * BM + wc * 32 + 8 * fq, pn = u.pn;
        float sc = 1.f; if (pn < 3 || (pn >= 9 && pn < 12)) sc = SCALE_A; else if (pn == 18 || pn == 19) sc = SCALE_C;
        const bool rp = (pn >= 18 && pn < 22) && ((wc & 1) == 0);
#pragma unroll
        for (int ai = 0; ai < 2; ++ai)
#pragma unroll
            for (int m = 0; m < 4; ++m) { const int row = row0 + ai * HALF + m * 16; bf16_t* rowp = O + (size_t)row * NPROJ + col0;
                f32x4 cs0 = {1.f, 1.f, 1.f, 1.f}, cs1 = cs0, sn0 = {0.f, 0.f, 0.f, 0.f}, sn1 = sn0;
                if (rp && fq < 2) { const f32x4* rr = (const f32x4*)(rope + (size_t)row * 16); cs0 = rr[0]; cs1 = rr[1]; sn0 = rr[2]; sn1 = rr[3]; if (fq == 0) { sn0 = -sn0; sn1 = -sn1; } }
#pragma unroll
                for (int bj = 0; bj < 2; ++bj) { f32x4 v0 = acc[ai][bj][m][0], v1 = acc[ai][bj][m][1];
                    if (rp) { f32x4 w0, w1;
#pragma unroll
                        for (int q = 0; q < 4; ++q) { w0[q] = sxor<16>(v0[q]); w1[q] = sxor<16>(v1[q]); }
                        v0 = v0 * cs0 + w0 * sn0; v1 = v1 * cs1 + w1 * sn1; }
                    v0 = v0 * sc; v1 = v1 * sc;
                    if (MK_QK8AB && (pn < 6 || (pn >= 9 && pn < 15))) {
                        const bool isq = pn < 3 || (pn >= 9 && pn < 12); const float s8 = isq ? fa_SQ8 : fa_SK8;
                        const int head = (pn < 6 ? (pn % 3) * 2 : 6 + ((pn - 9) % 3) * 2) + bj;
                        unsigned char* qp = (isq ? q8ab : k8ab) + ((size_t)head * S + row) * 128 + wc * 32 + 8 * fq;
                        u32x2 w8; w8.x = pk4_fp8(v0[0] * s8, v0[1] * s8, v0[2] * s8, v0[3] * s8); w8.y = pk4_fp8(v1[0] * s8, v1[1] * s8, v1[2] * s8, v1[3] * s8);
                        st8(qp, w8); }
                    if (MK_QK8AB && pn >= 9 && pn < 15) { }
                    else if (MK_QK8 && pn >= 18 && pn < 22) {
                        const float s8 = pn < 20 ? fa_SQ8 : fa_SK8; const int head = ((pn - 18) & 1) * 2 + bj;
                        unsigned char* qp = (pn < 20 ? q8 : k8) + ((size_t)(head * 2 + (wc >> 1)) * S + row) * 64 + (wc & 1) * 32 + 8 * fq;
                        u32x2 w; w.x = pk4_fp8(v0[0] * s8, v0[1] * s8, v0[2] * s8, v0[3] * s8); w.y = pk4_fp8(v1[0] * s8, v1[1] * s8, v1[2] * s8, v1[3] * s8);
                        st8(qp, w);
                    } else if (MK_PV8 && pn >= 22) {
                        const int head = (pn - 22) * 2 + bj, tile = 4 * u.pm + 2 * ai + wr, k = 16 * m + fr, kk = k & 31, kpos = 32 * ((kk >> 2) & 1) + 16 * (k >> 5) + (kk & 3) + 4 * (kk >> 3);
                        unsigned char* vp = vt8 + ((size_t)(head * 256 + tile) * 128 + wc * 32 + 8 * fq) * 64 + kpos;
                        const unsigned wa = pk4_fp8(v0[0] * fa_SV8, v0[1] * fa_SV8, v0[2] * fa_SV8, v0[3] * fa_SV8), wb = pk4_fp8(v1[0] * fa_SV8, v1[1] * fa_SV8, v1[2] * fa_SV8, v1[3] * fa_SV8);
#pragma unroll
                        for (int j = 0; j < 4; ++j) { vp[j * 64] = (unsigned char)(wa >> (8 * j)); vp[(4 + j) * 64] = (unsigned char)(wb >> (8 * j)); }
                    } else {
                    u32x4 w; w.x = cvt_pk_bf16(v0[0], v0[1]); w.y = cvt_pk_bf16(v0[2], v0[3]); w.z = cvt_pk_bf16(v1[0], v1[1]); w.w = cvt_pk_bf16(v1[2], v1[3]);
                    st16(rowp + bj * HALF, w); } } }
    }
};

__device__ __forceinline__ void glds16s(unsigned voff, const void* sbase, unsigned ldsaddr) { unsigned keep;
    asm volatile("s_mov_b32 %0, m0\n\ts_mov_b32 m0, %3\n\ts_nop 0\n\tglobal_load_lds_dwordx4 %1, %2\n\ts_mov_b32 m0, %0" : "=&s"(keep) : "v"(voff), "s"(sbase), "s"(ldsaddr) : "memory"); }
template <int K, class Epi, class Sched, bool FP8 = false, bool ALIGN_EPI = true, int NT_ = 0>
__device__ __forceinline__ void gemm_phase(LAS unsigned char* lds, const Gemm g, const Sched& S, const Epi& E, int wave_) {
    const int tid = launder_tid(wave_), wid = wave_, lane = tid & 63, wr = wid >> 2, wc = wid & 3, fr = lane & 15, fq = lane >> 4;
    constexpr int nt = NT_ ? NT_ : K / BK; constexpr size_t KSB = (size_t)nt * BK * 2;
    unsigned voffA, voffB;
    { int R, C; if constexpr (FP8) stage_rc8(tid * 16, R, C); else stage_rc(tid * 16, R, C); const int Rb = Epi::PERM ? ((R & ~31) + perm32(R & 31)) : R;
        voffA = (unsigned)(R * K + C) * 2u; voffB = (unsigned)(Rb * K + C) * 2u; }
    const size_t qstep = (size_t)64 * K * 2;
    const size_t kstep = (size_t)(BK * 2);
    const size_t hstep = (size_t)HALF * K * 2;
    const size_t tstep = 2 * hstep;
    const unsigned ldsb = (unsigned)(uintptr_t)lds + (unsigned)wid * 1024u;
    const int aoff = FP8 ? wr * 8192 + (fq * 16 + fr) * 16 : lds_byte(wr * 64 + fr, fq * 8), boff = FP8 ? wc * 4096 + (fq * 16 + fr) * 16 : lds_byte(wc * 32 + fr, fq * 8);
#define PG8_SA(b, h) (((b) * 2 + (h)) * HTB)
#define PG8_SB(b, h) ((4 + (b) * 2 + (h)) * HTB)
#define PG8_STAGE(bufoff, gbase, voff) do { _Pragma("unroll") for (int _i = 0; _i < 2; ++_i) glds16s((voff), (const void*)((const char*)(gbase) + _i * qstep), ldsb + (unsigned)((bufoff) + _i * 8192)); } while (0)
#define PG8_LDA(dst, b, h) do { if constexpr (FP8) { _Pragma("unroll") for (int m = 0; m < 4; ++m) { dst##8[m].lo = *(const LAS i32x4*)(lds + PG8_SA(b, h) + aoff + m * 2048); dst##8[m].hi = *(const LAS i32x4*)(lds + PG8_SA(b, h) + aoff + m * 2048 + 1024); } } \
        else { _Pragma("unroll") for (int m = 0; m < 4; ++m) _Pragma("unroll") for (int k = 0; k < 2; ++k) dst[m][k] = *(const LAS bf16x8*)(lds + PG8_SA(b, h) + aoff + m * 2048 + k * 1024); } } while (0)
#define PG8_LDB(dst, b, h) do { if constexpr (FP8) { _Pragma("unroll") for (int n = 0; n < 2; ++n) { dst##8[n].lo = *(const LAS i32x4*)(lds + PG8_SB(b, h) + boff + n * 2048); dst##8[n].hi = *(const LAS i32x4*)(lds + PG8_SB(b, h) + boff + n * 2048 + 1024); } } \
        else { _Pragma("unroll") for (int n = 0; n < 2; ++n) _Pragma("unroll") for (int k = 0; k < 2; ++k) dst[n][k] = *(const LAS bf16x8*)(lds + PG8_SB(b, h) + boff + n * 2048 + k * 1024); } } while (0)
#define PG8_MMA(ai, bj, At, Bt) do { __builtin_amdgcn_s_setprio(1); \
        if constexpr (FP8) { _Pragma("unroll") for (int m = 0; m < 4; ++m) _Pragma("unroll") for (int n = 0; n < 2; ++n) \
            acc[ai][bj][m][n] = __builtin_amdgcn_mfma_scale_f32_16x16x128_f8f6f4(Bt##8[n], At##8[m], acc[ai][bj][m][n], 0, 0, 0, 0, 0, 0); } \
        else { _Pragma("unroll") for (int m = 0; m < 4; ++m) _Pragma("unroll") for (int n = 0; n < 2; ++n) _Pragma("unroll") for (int k = 0; k < 2; ++k) \
            acc[ai][bj][m][n] = __builtin_amdgcn_mfma_f32_16x16x32_bf16(Bt[n][k], At[m][k], acc[ai][bj][m][n], 0, 0, 0); } \
        __builtin_amdgcn_s_setprio(0); } while (0)
#define PG8_WAIT_V(n) asm volatile("s_waitcnt vmcnt(" #n ")" ::: "memory")
#define PG8_WAIT_L(n) asm volatile("s_waitcnt lgkmcnt(" #n ")" ::: "memory")
#define PG8_BAR __builtin_amdgcn_s_barrier()
#define PG8_SCHED __builtin_amdgcn_sched_barrier(0)
    Unit cur, nxt; int ui = 0;
    if (!S.next(0, cur)) return;
    f32x4 acc[2][2][4][2];
#pragma unroll
    for (int a = 0; a < 2; ++a)
#pragma unroll
        for (int b = 0; b < 2; ++b)
#pragma unroll
            for (int m = 0; m < 4; ++m)
#pragma unroll
                for (int n = 0; n < 2; ++n) acc[a][b][m][n] = (f32x4){0.f, 0.f, 0.f, 0.f};
    bf16x8 At[4][2], B0[2][2], B1[2][2]; i32x8 At8[4], B08[2], B18[2];
    const char* cA = (const char*)g.A + (size_t)cur.pm * tstep + (NT_ ? (size_t)cur.ks * KSB : 0); const char* cB = (const char*)g.Bt + (size_t)cur.e * g.bstride + (size_t)cur.pn * tstep + (NT_ ? (size_t)cur.ks * KSB : 0);
    PG8_STAGE(PG8_SB(0, 0), cB, voffB); PG8_STAGE(PG8_SB(0, 1), cB + hstep, voffB); PG8_STAGE(PG8_SA(0, 0), cA, voffA); PG8_STAGE(PG8_SA(0, 1), cA + hstep, voffA);
    if (wr == 1) PG8_BAR;
    PG8_WAIT_V(2); PG8_BAR;
    PG8_STAGE(PG8_SB(1, 0), cB + kstep, voffB); PG8_STAGE(PG8_SA(1, 0), cA + kstep, voffA); PG8_STAGE(PG8_SB(1, 1), cB + hstep + kstep, voffB);
    PG8_WAIT_V(6); PG8_BAR;
    for (;;) {
        const bool has_next = S.next(ui + 1, nxt);
        const char* nA = has_next ? (const char*)g.A + (size_t)nxt.pm * tstep + (NT_ ? (size_t)nxt.ks * KSB : 0) : cA; const char* nB = has_next ? (const char*)g.Bt + (size_t)nxt.e * g.bstride + (size_t)nxt.pn * tstep + (NT_ ? (size_t)nxt.ks * KSB : 0) : cB;
        for (int t = 0; t < nt; t += 2) {
            const bool last = (t == nt - 2);
            const char* a1 = cA + (size_t)(t + 1) * kstep;
            const char* a2 = last ? nA : cA + (size_t)(t + 2) * kstep; const char* b2 = last ? nB : cB + (size_t)(t + 2) * kstep;
            const char* a3 = a2 + kstep; const char* b3 = b2 + kstep;
            PG8_LDB(B0, 0, 0); PG8_LDB(B1, 0, 1); PG8_SCHED; PG8_LDA(At, 0, 0); PG8_STAGE(PG8_SA(1, 1), a1 + hstep, voffA);
            PG8_WAIT_V(8); PG8_WAIT_L(0); PG8_BAR; PG8_MMA(0, 0, At, B0); PG8_MMA(0, 1, At, B1); PG8_BAR; PG8_SCHED;
            PG8_LDA(At, 0, 1); PG8_STAGE(PG8_SB(0, 0), b2, voffB); PG8_STAGE(PG8_SB(0, 1), b2 + hstep, voffB); PG8_STAGE(PG8_SA(0, 0), a2, voffA);
            PG8_WAIT_V(8); PG8_WAIT_L(0); PG8_BAR; PG8_MMA(1, 0, At, B0); PG8_MMA(1, 1, At, B1); PG8_BAR; PG8_SCHED;
            PG8_LDB(B0, 1, 0); PG8_LDB(B1, 1, 1); PG8_SCHED; PG8_LDA(At, 1, 0); PG8_STAGE(PG8_SA(0, 1), a2 + hstep, voffA);
            PG8_WAIT_V(8); PG8_WAIT_L(0); PG8_BAR; PG8_MMA(0, 0, At, B0); PG8_MMA(0, 1, At, B1); PG8_BAR; PG8_SCHED;
            PG8_LDA(At, 1, 1); PG8_STAGE(PG8_SB(1, 0), b3, voffB); PG8_STAGE(PG8_SB(1, 1), b3 + hstep, voffB); PG8_STAGE(PG8_SA(1, 0), a3, voffA);
            PG8_WAIT_V(8); PG8_WAIT_L(0); PG8_BAR; PG8_MMA(1, 0, At, B0); PG8_MMA(1, 1, At, B1); PG8_BAR; PG8_SCHED;
        }
        if constexpr (ALIGN_EPI) { if (wr == 0) PG8_BAR; }
        if constexpr (FP8) { const int ln_ = lane_now(); E(acc, cur, wr, wc, ln_ & 15, ln_ >> 4); }
        else E(acc, cur, wr, wc, fr, fq);
        if (!has_next) break;
#pragma unroll
        for (int a = 0; a < 2; ++a)
#pragma unroll
            for (int b = 0; b < 2; ++b)
#pragma unroll
                for (int m = 0; m < 4; ++m)
#pragma unroll
                    for (int n = 0; n < 2; ++n) acc[a][b][m][n] = (f32x4){0.f, 0.f, 0.f, 0.f};
        cur = nxt; cA = nA; cB = nB; ++ui;
        if constexpr (ALIGN_EPI) { if (wr == 1) PG8_BAR; }
    }
    PG8_WAIT_V(0);
    if constexpr (!ALIGN_EPI) { if (wr == 0) PG8_BAR; }
    PG8_BAR;
#undef PG8_SA
#undef PG8_SB
#undef PG8_STAGE
#undef PG8_LDA
#undef PG8_LDB
#undef PG8_MMA
#undef PG8_WAIT_V
#undef PG8_WAIT_L
#undef PG8_BAR
#undef PG8_SCHED
}
}

typedef GAS unsigned gu32;
#define RLX_AGENT __ATOMIC_RELAXED, __HIP_MEMORY_SCOPE_AGENT
#define XB_TMO      128
#define XB_XCNT(j)  (256  + 64 * (j))
#define XB_XSUB(j)  (1280 + 64 * (j))
#define XB_XGEN(j)  (2304 + 64 * (j))
#define XB_TOP      3328
#define XB_TOPGEN   3392
#define XCD_BAR_WORDS 3456
#define XB_SPIN_CAP (1u << 22)
__device__ __forceinline__ unsigned xb_ld(unsigned* p)              { return __hip_atomic_load(p, __ATOMIC_RELAXED, __HIP_MEMORY_SCOPE_AGENT); }
__device__ __forceinline__ unsigned xb_add(unsigned* p, unsigned v) { return __hip_atomic_fetch_add(p, v, __ATOMIC_RELAXED, __HIP_MEMORY_SCOPE_AGENT); }
__device__ __forceinline__ unsigned xb_xcc_id() { return (unsigned)__builtin_amdgcn_s_getreg((3 << 11) | 20) & 0xFu; }
#define XB_SPIN(cond, bar) do { unsigned _sp = 0; while (cond) { __builtin_amdgcn_s_sleep(1); \
    if ((++_sp & 255u) == 0u) { if (xb_ld(&(bar)[XB_TMO])) break; if (_sp > XB_SPIN_CAP) { atomicAdd(&(bar)[XB_TMO], 1u); break; } } } } while (0)
struct XcdBarrier { unsigned* bar; unsigned x; volatile LAS unsigned* st; };
__device__ __forceinline__ XcdBarrier xcd_barrier_post(unsigned* bar, volatile LAS unsigned* st) {
    XcdBarrier b; b.bar = bar; b.x = xb_xcc_id(); b.st = st;
    if (threadIdx.x == 0) (void)xb_add(&bar[XB_XCNT(b.x)], 1u);
    b.x = 0;
    return b;
}
__device__ __forceinline__ void xcd_barrier_complete(unsigned* bar, unsigned x, unsigned& nloc, unsigned& nx) {
    const unsigned G = gridDim.x * gridDim.y * gridDim.z;
    unsigned sum, cnt, mine, sp = 0u;
    for (;;) {
        sum = 0u; cnt = 0u; mine = 0u;
#pragma unroll
        for (unsigned j = 0; j < 16; ++j) { const unsigned c = xb_ld(&bar[XB_XCNT(j)]); sum += c; cnt += (c > 0u) ? 1u : 0u; mine = (j == x) ? c : mine; }
        if (sum == G) break;
        __builtin_amdgcn_s_sleep(1);
        if ((++sp & 255u) == 0u) { if (xb_ld(&bar[XB_TMO])) break; if (sp > XB_SPIN_CAP) { atomicAdd(&bar[XB_TMO], 1u); break; } }
    }
    nloc = mine > 0u ? mine : 1u; nx = cnt > 0u ? cnt : 1u;
}
__device__ __forceinline__ void xcd_barrier(const XcdBarrier& b, int wave_, unsigned* barp) {
    asm volatile("s_waitcnt vmcnt(0)" ::: "memory");
    __syncthreads();
    if (wave_ == 0 && lane_now() == 0) {
        unsigned* bar = barp;
        __builtin_amdgcn_s_waitcnt(0);
        const unsigned bx_ = xb_xcc_id();
        unsigned nloc = b.st[0], nx = b.st[1];
        if (nloc == 0u) { xcd_barrier_complete(bar, bx_, nloc, nx); b.st[0] = nloc; b.st[1] = nx; }
        const unsigned old = xb_add(&bar[XB_XSUB(bx_)], 1u);
        const unsigned gen = old / nloc;
        if (old + 1u == (gen + 1u) * nloc) {
            __builtin_amdgcn_fence(__ATOMIC_RELEASE, "agent");
            asm volatile("s_waitcnt vmcnt(0)" ::: "memory");
            const unsigned og = xb_add(&bar[XB_TOP], 1u);
            const unsigned tg = og / nx;
            if (og + 1u == (tg + 1u) * nx) xb_add(&bar[XB_TOPGEN], 1u);
            else XB_SPIN(xb_ld(&bar[XB_TOPGEN]) == tg, bar);
            __builtin_amdgcn_fence(__ATOMIC_ACQUIRE, "agent");
            xb_add(&bar[XB_XGEN(bx_)], 1u);
            asm volatile("s_waitcnt vmcnt(0)" ::: "memory");
        } else {
            XB_SPIN(xb_ld(&bar[XB_XGEN(bx_)]) == gen, bar);
            __builtin_amdgcn_fence(__ATOMIC_ACQUIRE, "agent");
            asm volatile("s_waitcnt vmcnt(0)" ::: "memory");
        }
    }
    __syncthreads();
}

struct Frame {
    LAS unsigned char* lds;
    int tid, lane, wave, vcu, G;
    unsigned char* ws;
    const void* const* ka;
    float* out;
};
#define FIN_x(F) ((const float*)(F).ka[opq(0)])
#define FIN_c(F) ((const float*)(F).ka[opq(1)])
#define FIN_positions(F) ((const int*)(F).ka[opq(2)])
#define FIN_mod_w(F) ((const float*)(F).ka[opq(3)])
#define FIN_mod_b(F) ((const float*)(F).ka[opq(4)])
#define FIN_norm_g(F) ((const float*)(F).ka[opq(5)])
#define FIN_w_in(F) ((const float*)(F).ka[opq(6)])
#define FIN_b_f(F) ((const float*)(F).ka[opq(7)])
#define FIN_rel_bias(F) ((const float*)(F).ka[opq(8)])
#define FIN_lam(F) ((const float*)(F).ka[opq(9)])
#define FIN_onorm(F) ((const float*)(F).ka[opq(10)])
#define FIN_w_o(F) ((const float*)(F).ka[opq(11)])
#define FIN_ffn_wg(F) ((const float*)(F).ka[opq(12)])
#define FIN_ffn_wu(F) ((const float*)(F).ka[opq(13)])
#define FIN_ffn_wd(F) ((const float*)(F).ka[opq(14)])
#define FIN_router_w(F) ((const float*)(F).ka[opq(15)])
#define FIN_router_b(F) ((const float*)(F).ka[opq(16)])
#define FIN_exp_wg(F) ((const float*)(F).ka[opq(17)])
#define FIN_exp_wu(F) ((const float*)(F).ka[opq(18)])
#define FIN_exp_wd(F) ((const float*)(F).ka[opq(19)])
template <class T> __device__ __forceinline__ T* wsp(const Frame& F, size_t off) { return (T*)(F.ws + off); }
__device__ __forceinline__ void frame_tid(Frame& F) { F.tid = launder_tid(F.wave); F.lane = F.tid & 63;
    F.ws = (unsigned char*)F.ka[opq(21)]; F.out = (float*)F.ka[opq(20)]; }

__device__ __forceinline__ void transpose_tile(const float* src, size_t ld, int k0, int c0, bf16_t* dst, int dK, int drow0, LAS float* scr, int lane) {
    const float* s = src + (size_t)k0 * ld + c0 + lane;
#pragma unroll 16
    for (int i = 0; i < 64; ++i) scr[i * 65 + lane] = __builtin_nontemporal_load(s + (size_t)i * ld);
    LDS_WAIT(); asm volatile("" ::: "memory");
    const int c = lane & 7;
#pragma unroll
    for (int j = 0; j < 8; ++j) { const int n = (lane >> 3) + 8 * j; const LAS float* p = scr + (8 * c) * 65 + n;
        u32x4 o; o.x = cvt_pk_bf16(p[0 * 65], p[1 * 65]); o.y = cvt_pk_bf16(p[2 * 65], p[3 * 65]); o.z = cvt_pk_bf16(p[4 * 65], p[5 * 65]); o.w = cvt_pk_bf16(p[6 * 65], p[7 * 65]);
        *(u32x4*)(dst + (size_t)(drow0 + n) * dK + k0 + 8 * c) = o; }
    LDS_WAIT(); asm volatile("" ::: "memory");
}
__device__ __forceinline__ void transpose_tile8(const float* src, size_t ld, int k0, int c0, unsigned char* dst, int dK, int drow0, float scl, LAS float* scr, int lane) {
    const int c = lane & 3; u32x4 o[2][4];
#pragma unroll
    for (int hf = 0; hf < 2; ++hf) {
        const float* s = src + (size_t)(k0 + 64 * hf) * ld + c0 + lane;
#pragma unroll 16
        for (int i = 0; i < 64; ++i) scr[i * 65 + lane] = __builtin_nontemporal_load(s + (size_t)i * ld);
        LDS_WAIT(); asm volatile("" ::: "memory");
#pragma unroll
        for (int j = 0; j < 4; ++j) { const int n = (lane >> 2) + 16 * j; const LAS float* p = scr + (16 * c) * 65 + n;
            o[hf][j].x = pk4_fp8(p[0 * 65] * scl, p[1 * 65] * scl, p[2 * 65] * scl, p[3 * 65] * scl); o[hf][j].y = pk4_fp8(p[4 * 65] * scl, p[5 * 65] * scl, p[6 * 65] * scl, p[7 * 65] * scl);
            o[hf][j].z = pk4_fp8(p[8 * 65] * scl, p[9 * 65] * scl, p[10 * 65] * scl, p[11 * 65] * scl); o[hf][j].w = pk4_fp8(p[12 * 65] * scl, p[13 * 65] * scl, p[14 * 65] * scl, p[15 * 65] * scl); }
        LDS_WAIT(); asm volatile("" ::: "memory");
    }
#pragma unroll
    for (int j = 0; j < 4; ++j) { const int n = (lane >> 2) + 16 * j; unsigned char* d = dst + (size_t)(drow0 + n) * dK + k0 + 16 * c;
        *(u32x4*)d = o[0][j]; *(u32x4*)(d + 64) = o[1][j]; }
}
__device__ __forceinline__ void transpose_tile8x(const float* src, size_t ld, int k0, int c0, unsigned char* dst, int dK, int drow0, float scl, LAS float* scr, int lane) {
    const int c = lane & 3; u32x4 o[2][4];
    const float* s = src + (size_t)k0 * ld + c0 + lane;
    float v[64];
#pragma unroll
    for (int i = 0; i < 64; ++i) v[i] = __builtin_nontemporal_load(s + (size_t)i * ld);
#pragma unroll
    for (int hf = 0; hf < 2; ++hf) {
#pragma unroll
        for (int i = 0; i < 64; ++i) scr[i * 65 + lane] = v[i];
        if (hf == 0) {
#pragma unroll
            for (int i = 0; i < 64; ++i) v[i] = __builtin_nontemporal_load(s + (size_t)(64 + i) * ld);
        }
        LDS_WAIT(); asm volatile("" ::: "memory");
#pragma unroll
        for (int j = 0; j < 4; ++j) { const int n = (lane >> 2) + 16 * j; const LAS float* p = scr + (16 * c) * 65 + n;
            o[hf][j].x = pk4_fp8(p[0 * 65] * scl, p[1 * 65] * scl, p[2 * 65] * scl, p[3 * 65] * scl); o[hf][j].y = pk4_fp8(p[4 * 65] * scl, p[5 * 65] * scl, p[6 * 65] * scl, p[7 * 65] * scl);
            o[hf][j].z = pk4_fp8(p[8 * 65] * scl, p[9 * 65] * scl, p[10 * 65] * scl, p[11 * 65] * scl); o[hf][j].w = pk4_fp8(p[12 * 65] * scl, p[13 * 65] * scl, p[14 * 65] * scl, p[15 * 65] * scl); }
        LDS_WAIT(); asm volatile("" ::: "memory");
    }
#pragma unroll
    for (int j = 0; j < 4; ++j) { const int n = (lane >> 2) + 16 * j; unsigned char* d = dst + (size_t)(drow0 + n) * dK + k0 + 16 * c;
        *(u32x4*)d = o[0][j]; *(u32x4*)(d + 64) = o[1][j]; }
}
constexpr int NCV = 896;
__device__ __forceinline__ void expert_conv_item(Frame& F, int k) {
    LAS float* scr = (LAS float*)(F.lds + F.wave * 16640);
    const int lane = launder_tid(F.wave) & 63, c = lane & 3;
    constexpr int I_F8 = 1792;
    const float* sp[3]; size_t ldv[3]; unsigned char* dp[3]; int dkv[3]; float scv[3];
#pragma unroll
    for (int j = 0; j < 3; ++j) { int r = k * 24 + F.wave * 3 + j;
        const int mj = r / I_F8; r -= mj * I_F8; const int e = mj / 3, kind = mj % 3; const size_t eo = (size_t)e * D * DFF;
        const float* src = (const float*)F.ka[opq(17 + kind)] + eo; unsigned char* dst = (kind == 2) ? wsp<unsigned char>(F, WS_ED) + eo : wsp<unsigned char>(F, WS_EGU) + 2 * eo;
        if (kind < 2) { const int kb = r / 112, nb = r % 112, n0 = nb * 64; const int drow0 = 256 * (n0 >> 7) + (n0 & 127) + 128 * kind;
            sp[j] = src + (size_t)(kb * 128) * DFF + n0 + lane; ldv[j] = DFF; dp[j] = dst + (size_t)drow0 * D + kb * 128; dkv[j] = D; scv[j] = SW8; }
        else { const int kb = r / 32, nb = r % 32;
            sp[j] = src + (size_t)(kb * 128) * D + nb * 64 + lane; ldv[j] = D; dp[j] = dst + (size_t)(nb * 64) * DFF + kb * 128; dkv[j] = DFF; scv[j] = SWD8; } }
    float v[64]; u32x4 o[2][4];
#pragma unroll
    for (int i = 0; i < 64; ++i) v[i] = __builtin_nontemporal_load(sp[0] + (size_t)i * ldv[0]);
#pragma unroll
    for (int idx = 0; idx < 6; ++idx) { const int t = idx >> 1, hf = idx & 1;
#pragma unroll
        for (int i = 0; i < 64; ++i) scr[i * 65 + lane] = v[i];
        if (idx < 5) { const int t2 = (idx + 1) >> 1, h2 = (idx + 1) & 1; const float* s2 = sp[t2] + (size_t)(64 * h2) * ldv[t2];
#pragma unroll
            for (int i = 0; i < 64; ++i) v[i] = __builtin_nontemporal_load(s2 + (size_t)i * ldv[t2]); }
        LDS_WAIT(); asm volatile("" ::: "memory");
        const float scl = scv[t];
#pragma unroll
        for (int j = 0; j < 4; ++j) { const int n = (lane >> 2) + 16 * j; const LAS float* p = scr + (16 * c) * 65 + n;
            o[hf][j].x = pk4_fp8(p[0 * 65] * scl, p[1 * 65] * scl, p[2 * 65] * scl, p[3 * 65] * scl); o[hf][j].y = pk4_fp8(p[4 * 65] * scl, p[5 * 65] * scl, p[6 * 65] * scl, p[7 * 65] * scl);
            o[hf][j].z = pk4_fp8(p[8 * 65] * scl, p[9 * 65] * scl, p[10 * 65] * scl, p[11 * 65] * scl); o[hf][j].w = pk4_fp8(p[12 * 65] * scl, p[13 * 65] * scl, p[14 * 65] * scl, p[15 * 65] * scl); }
        LDS_WAIT(); asm volatile("" ::: "memory");
        if (hf) {
#pragma unroll
            for (int j = 0; j < 4; ++j) { const int n = (lane >> 2) + 16 * j; unsigned char* d = dp[t] + (size_t)n * dkv[t] + 16 * c;
                *(u32x4*)d = o[0][j]; *(u32x4*)(d + 64) = o[1][j]; } }
    }
}
__device__ __forceinline__ void p0_prologue(Frame& F) {

    LAS float* scr = (LAS float*)(F.lds + F.wave * 16640);
    const int gw = F.vcu * 8 + F.wave, NGW = F.G * 8, lane = F.lane;
    constexpr int I_IN = 32 * 96, I_O = 32 * 32, I_F = 3584, I_F8 = 1792;
    constexpr int NIT = 2 * I_IN + 2 * I_O + (MK_DENSE_FP8 ? 3 * I_F8 : MK_DENSE_DN8 ? 2 * I_F + I_F8 : 3 * I_F) + (MK_XCONV ? 0 : 24 * I_F8);
    for (int it = gw; it < NIT; it += NGW) {
        int r = it;
        if (r < 2 * I_IN) { const int l = r / I_IN; r -= l * I_IN; const int kb = r / 96, nb = r % 96, n0 = nb * 64;
            transpose_tile(FIN_w_in(F) + (size_t)l * D * DIN, DIN, kb * 64, n0 + (n0 >= 2304 ? 6 : 0), wsp<bf16_t>(F, WS_WIN) + (size_t)l * NPROJ * D, D, n0, scr, lane); continue; }
        r -= 2 * I_IN;
        if (r < 2 * I_O) { const int l = r / I_O; r -= l * I_O; const int kb = r / 32, nb = r % 32;
            transpose_tile(FIN_w_o(F) + (size_t)l * D * D, D, kb * 64, nb * 64, wsp<bf16_t>(F, WS_WO) + (size_t)l * D * D, D, nb * 64, scr, lane); continue; }
        r -= 2 * I_O;
#if MK_DENSE_FP8
        if (r < 3 * I_F8) { const int kind = r / I_F8; r -= kind * I_F8; const float* src = (const float*)F.ka[12 + kind]; unsigned char* dst = (kind == 2) ? wsp<unsigned char>(F, WS_WD) : wsp<unsigned char>(F, WS_WGU);
            if (kind < 2) { const int kb = r / 112, nb = r % 112, n0 = nb * 64; const int drow0 = 256 * (n0 >> 7) + (n0 & 127) + 128 * kind;
                transpose_tile8(src, DFF, kb * 128, n0, dst, D, drow0, SW8, scr, lane); }
            else { const int kb = r / 32, nb = r % 32; transpose_tile8(src, D, kb * 128, nb * 64, dst, DFF, nb * 64, SWD8, scr, lane); }
            continue; }
        r -= 3 * I_F8;
#elif MK_DENSE_DN8
        if (r < 2 * I_F) { const int kind = r / I_F; r -= kind * I_F; const float* src = (const float*)F.ka[12 + kind]; bf16_t* dst = wsp<bf16_t>(F, WS_WGU);
            const int kb = r / 112, nb = r % 112, n0 = nb * 64; const int drow0 = 256 * (n0 >> 7) + (n0 & 127) + 128 * kind;
            transpose_tile(src, DFF, kb * 64, n0, dst, D, drow0, scr, lane); continue; }
        r -= 2 * I_F;
        if (r < I_F8) { const int kb = r / 32, nb = r % 32; transpose_tile8((const float*)F.ka[14], D, kb * 128, nb * 64, wsp<unsigned char>(F, WS_WD), DFF, nb * 64, SWD8, scr, lane); continue; }
        r -= I_F8;
#else
        if (r < 3 * I_F) { const int kind = r / I_F; r -= kind * I_F; const float* src = (const float*)F.ka[12 + kind]; bf16_t* dst = (kind == 2) ? wsp<bf16_t>(F, WS_WD) : wsp<bf16_t>(F, WS_WGU);
            if (kind < 2) { const int kb = r / 112, nb = r % 112, n0 = nb * 64; const int drow0 = 256 * (n0 >> 7) + (n0 & 127) + 128 * kind;
                transpose_tile(src, DFF, kb * 64, n0, dst, D, drow0, scr, lane); }
            else { const int kb = r / 32, nb = r % 32; transpose_tile(src, D, kb * 64, nb * 64, dst, DFF, nb * 64, scr, lane); }
            continue; }
        r -= 3 * I_F;
#endif
        { const int mj = r / I_F8; r -= mj * I_F8; const int e = mj / 3, kind = mj % 3; const size_t eo = (size_t)e * D * DFF;
            const float* src = (const float*)F.ka[17 + kind] + eo; unsigned char* dst = (kind == 2) ? wsp<unsigned char>(F, WS_ED) + eo : wsp<unsigned char>(F, WS_EGU) + 2 * eo;
            if (kind < 2) { const int kb = r / 112, nb = r % 112, n0 = nb * 64; const int drow0 = 256 * (n0 >> 7) + (n0 & 127) + 128 * kind;
                transpose_tile8(src, DFF, kb * 128, n0, dst, D, drow0, SW8, scr, lane); }
            else { const int kb = r / 32, nb = r % 32; transpose_tile8(src, D, kb * 128, nb * 64, dst, DFF, nb * 64, SWD8, scr, lane); } }
    }
    {   float* modp = wsp<float>(F, WS_MODP);
        constexpr int NU = 2 * 48 * NMODP;
        for (int u = gw; u < NU; u += NGW) { const int p = u % NMODP, cg = (u / NMODP) % 48, l = u / (NMODP * 48);
            const float* w = FIN_mod_w(F) + (size_t)l * D * 6 * D + (size_t)(p * 128) * 6 * D + cg * 256 + 4 * lane; const float* cvp = FIN_c(F) + p * 128;
            f32x4 a = {0.f, 0.f, 0.f, 0.f};
#pragma unroll 16
            for (int d = 0; d < 128; ++d) { const float cv = cvp[d]; const float sv = cv / (1.0f + __expf(-cv)); a += *(const f32x4*)(w + (size_t)d * 6 * D) * sv; }
            float* mo = modp + ((size_t)l * 6 * D + cg * 256 + 4 * lane) * NMODP + p; mo[0] = a.x; mo[NMODP] = a.y; mo[2 * NMODP] = a.z; mo[3 * NMODP] = a.w; }
    }
    {   float* rope = wsp<float>(F, WS_ROPE);
        const int gt = (F.vcu * 8 + F.wave) * 64 + lane, NT = F.G * 512; const int* posp = FIN_positions(F);
        for (int i = gt; i < S * 8; i += NT) { const int t = i >> 3, j = i & 7;
            const float inv = (float)exp2(-(double)j * 0.125 * 18.931568569324174);
            const float ang = (float)posp[t] * inv;
            const double a = (double)ang, kq = rint(a * 0.15915494309189535), r = (a - kq * 6.283185307179586) - kq * 2.4492935982947064e-16;
            const double r2 = r * r; double sn = 0.0, cs = 0.0;
            { double term = r; sn = r;
#pragma unroll
              for (int n = 1; n < 14; ++n) { term *= -r2 / (double)((2 * n) * (2 * n + 1)); sn += term; } }
            { double term = 1.0; cs = 1.0;
#pragma unroll
              for (int n = 1; n < 14; ++n) { term *= -r2 / (double)((2 * n - 1) * (2 * n)); cs += term; } }
            rope[(size_t)t * 16 + j] = (float)cs; rope[(size_t)t * 16 + 8 + j] = (float)sn; }
    }
    if (blockIdx.x == 0) { int* tl = wsp<int>(F, WS_TILES); for (int i = F.tid; i < 256; i += 512) tl[i] = (i == 0) ? 64 : 0; }
}

__device__ __forceinline__ float modv(const Frame& F, int l, int k, int c) {
    const f32x4* mp = (const f32x4*)(wsp<float>(F, WS_MODP) + ((size_t)l * 6 * D + k * D + c) * NMODP);
    const f32x4 a = mp[0], b = mp[1], c4 = mp[2], d = mp[3];
    const float s = FIN_mod_b(F)[l * 6 * D + k * D + c] + (((a.x + a.y) + (a.z + a.w)) + ((b.x + b.y) + (b.z + b.w))) + (((c4.x + c4.y) + (c4.z + c4.w)) + ((d.x + d.y) + (d.z + d.w)));
    return s;
}
template <int RMODE>
__device__ __forceinline__ void row_phase(Frame& F, int l, bool dry = false) {
    constexpr bool HAS_Y = RMODE != 0, HAS_H = RMODE != 4, Y_MOE = RMODE == 4;
    constexpr int NX = (RMODE == 0 || RMODE == 1) ? 6 : (RMODE == 3 ? 8 : 0);
    LAS float* L = (LAS float*)F.lds;
    LAS float* vB = L; LAS float* vA = L + 2048; LAS float* vS = L + 4096; LAS float* wX = L + 6144;
    for (int c = F.tid; c < D; c += 512) {
        if (RMODE == 0 || RMODE == 1) { vA[c] = FIN_norm_g(F)[(l * 4 + 0) * D + c] * (1.0f + modv(F, l, 1, c)); vS[c] = modv(F, l, 0, c);
            if (RMODE == 1) vB[c] = modv(F, l - 1, 5, c) * FIN_norm_g(F)[((l - 1) * 4 + 3) * D + c];
#pragma unroll
            for (int a = 0; a < 6; ++a) wX[a * D + c] = FIN_w_in(F)[(size_t)l * D * DIN + (size_t)c * DIN + 2304 + a]; }
        if (RMODE == 2 || RMODE == 3) { vB[c] = modv(F, l, 2, c) * FIN_norm_g(F)[(l * 4 + 1) * D + c]; vA[c] = FIN_norm_g(F)[(l * 4 + 2) * D + c] * (1.0f + modv(F, l, 4, c)); vS[c] = modv(F, l, 3, c);
            if (RMODE == 3) {
#pragma unroll
                for (int e = 0; e < 8; ++e) wX[e * D + c] = FIN_router_w(F)[c * 8 + e]; } }
        if (RMODE == 4) vB[c] = modv(F, l, 5, c) * FIN_norm_g(F)[(l * 4 + 3) * D + c];
    }
    __syncthreads();
    const int gw = F.vcu * 8 + F.wave, NGW = F.G * 8, lane = F.lane;
    constexpr bool XIN_F32 = (RMODE == 0 || RMODE == 2), XOUT_F32 = (RMODE == 4);
    const float* xin = FIN_x(F); const bf16_t* xinb = wsp<bf16_t>(F, WS_XB); const float* bfp = FIN_b_f(F) + l * 6; const float* rbp = FIN_router_b(F);
    const bf16_t* Y = (RMODE == 4) ? wsp<bf16_t>(F, WS_YP) : wsp<bf16_t>(F, WS_Y);
    bool ysplit = false; if (RMODE == 4) { const int ntl_ = __builtin_amdgcn_readfirstlane((wsp<int>(F, WS_TILES) + 256)[0]); ysplit = (F.G == 256 && ntl_ >= 128 && ntl_ < 160); }
    bf16_t* H = dry ? wsp<bf16_t>(F, WS_BIG + 160 * MiB) : wsp<bf16_t>(F, WS_H); float* xout = dry ? wsp<float>(F, WS_BIG) : F.out; bf16_t* xoutb = dry ? wsp<bf16_t>(F, WS_BIG) : wsp<bf16_t>(F, WS_XB);
    for (int t = gw; t < S; t += NGW) {
        f32x4 xv[8];
#pragma unroll
        for (int j = 0; j < 8; ++j) { if constexpr (XIN_F32) xv[j] = __builtin_nontemporal_load((const f32x4*)(xin + (size_t)t * D + 4 * lane + 256 * j));
            else { const u32x2 a = __builtin_nontemporal_load((const u32x2*)(xinb + (size_t)t * D + 4 * lane + 256 * j)); xv[j] = (f32x4){bf_lo(a.x), bf_hi(a.x), bf_lo(a.y), bf_hi(a.y)}; } }
        if constexpr (HAS_Y) {
            f32x4 yv[8];
            if constexpr (Y_MOE) {
                const int s1 = wsp<int>(F, WS_TOKS)[2 * t], s2 = wsp<int>(F, WS_TOKS)[2 * t + 1]; const float g1 = wsp<float>(F, WS_TOKG)[2 * t], g2 = wsp<float>(F, WS_TOKG)[2 * t + 1];
                auto yrow = [&](int sl, int j) -> f32x4 {
                    if (ysplit && (sl >> 8) >= 128) { const float* q = wsp<float>(F, WS_YPS) + (size_t)(((sl >> 8) - 128) * 256 + (sl & 255)) * D + 4 * lane + 256 * j; constexpr size_t KS = (size_t)8 * 256 * D;
                        return ((*(const f32x4*)q + *(const f32x4*)(q + KS)) + (*(const f32x4*)(q + 2 * KS) + *(const f32x4*)(q + 3 * KS))) * (1.0f / (SA8 * SWD8)); }
                    const u32x2 a = __builtin_nontemporal_load((const u32x2*)(Y + (size_t)sl * D + 4 * lane + 256 * j)); return (f32x4){bf_lo(a.x), bf_hi(a.x), bf_lo(a.y), bf_hi(a.y)}; };
#pragma unroll
                for (int j = 0; j < 8; ++j) yv[j] = yrow(s1, j) * g1 + yrow(s2, j) * g2;
            } else {
#pragma unroll
                for (int j = 0; j < 8; ++j) { const u32x2 a = __builtin_nontemporal_load((const u32x2*)(Y + (size_t)t * D + 4 * lane + 256 * j)); yv[j] = (f32x4){bf_lo(a.x), bf_hi(a.x), bf_lo(a.y), bf_hi(a.y)}; }
            }
            float ss = 0.f;
#pragma unroll
            for (int j = 0; j < 8; ++j) ss += (yv[j].x * yv[j].x + yv[j].y * yv[j].y) + (yv[j].z * yv[j].z + yv[j].w * yv[j].w);
            const float rstd = rsqrtf(wave_sum(ss) * (1.0f / D) + EPS);
#pragma unroll
            for (int j = 0; j < 8; ++j) { const f32x4 gb = *(const LAS f32x4*)(vB + 4 * lane + 256 * j); xv[j] += gb * (yv[j] * rstd);
                if constexpr (XOUT_F32) __builtin_nontemporal_store(xv[j], (f32x4*)(xout + (size_t)t * D + 4 * lane + 256 * j));
                else { u32x2 w; w.x = cvt_pk_bf16(xv[j].x, xv[j].y); w.y = cvt_pk_bf16(xv[j].z, xv[j].w); *(u32x2*)(xoutb + (size_t)t * D + 4 * lane + 256 * j) = w;
                    xv[j] = (f32x4){bf_lo(w.x), bf_hi(w.x), bf_lo(w.y), bf_hi(w.y)}; } }
        }
        if constexpr (HAS_H) {
            float ss = 0.f;
#pragma unroll
            for (int j = 0; j < 8; ++j) ss += (xv[j].x * xv[j].x + xv[j].y * xv[j].y) + (xv[j].z * xv[j].z + xv[j].w * xv[j].w);
            const float rstd = rsqrtf(wave_sum(ss) * (1.0f / D) + EPS);
            float dots[NX > 0 ? NX : 1];
#pragma unroll
            for (int e = 0; e < NX; ++e) dots[e] = 0.f;
#pragma unroll
            for (int j = 0; j < 8; ++j) { const f32x4 ga = *(const LAS f32x4*)(vA + 4 * lane + 256 * j), sh = *(const LAS f32x4*)(vS + 4 * lane + 256 * j);
                const f32x4 hv = (xv[j] * rstd) * ga + sh;
                if constexpr (RMODE == 2 && MK_DENSE_FP8) { *(unsigned*)((unsigned char*)H + (size_t)t * D + 4 * lane + 256 * j) = pk4_fp8(hv.x * SH8, hv.y * SH8, hv.z * SH8, hv.w * SH8); }
                else { u32x2 w; w.x = cvt_pk_bf16(hv.x, hv.y); w.y = cvt_pk_bf16(hv.z, hv.w); *(u32x2*)(H + (size_t)t * D + 4 * lane + 256 * j) = w; }
#pragma unroll
                for (int e = 0; e < NX; ++e) { const f32x4 wv = *(const LAS f32x4*)(wX + e * D + 4 * lane + 256 * j); dots[e] += (hv.x * wv.x + hv.y * wv.y) + (hv.z * wv.z + hv.w * wv.w); } }
#pragma unroll
            for (int e = 0; e < NX; ++e) dots[e] = wave_sum(dots[e]);
            if constexpr (NX == 6) {
                if (lane < 6) { float z = 0.f;
#pragma unroll
                    for (int e = 0; e < 6; ++e) z = (lane == e) ? dots[e] : z;
                    z += bfp[lane];
                    const float ls = fminf(z, 0.f) - __builtin_amdgcn_logf(1.0f + __builtin_amdgcn_exp2f(-fabsf(z) * LOG2E)) * 0.6931471805599453f;
                    wsp<float>(F, WS_LOGF)[(size_t)t * 8 + lane] = ls; }
            }
            if constexpr (NX == 8) {
                if (lane == 0) { float v[8];
#pragma unroll
                    for (int e = 0; e < 8; ++e) v[e] = dots[e] + rbp[e];
                    int i1 = 0; float v1 = v[0];
#pragma unroll
                    for (int e = 1; e < 8; ++e) if (v[e] > v1) { v1 = v[e]; i1 = e; }
                    int i2 = -1; float v2 = -3.0e38f;
#pragma unroll
                    for (int e = 0; e < 8; ++e) if (e != i1 && v[e] > v2) { v2 = v[e]; i2 = e; }
                    const float e2 = __expf(v2 - v1), g1 = 1.0f / (1.0f + e2), g2 = e2 * g1;
                    wsp<unsigned>(F, WS_TOKE)[t] = (unsigned)i1 | ((unsigned)i2 << 8);
                    wsp<float>(F, WS_TOKG)[2 * t] = g1; wsp<float>(F, WS_TOKG)[2 * t + 1] = g2; }
            }
        }
    }
    __syncthreads();
}

__device__ __forceinline__ void scan_head(Frame& F, int a) {
    const int tid = launder_tid(F.wave);
    LAS double* sd = (LAS double*)F.lds; LAS double* sbase = sd + 512;
    const float* lf = wsp<float>(F, WS_LOGF);
    double loc = 0.0;
    for (int i = 0; i < 32; ++i) loc += (double)lf[(size_t)(32 * tid + i) * 8 + a];
    sd[tid] = loc; __syncthreads();
    for (int o = 1; o < 512; o <<= 1) { const double v = (tid >= o) ? sd[tid - o] : 0.0; __syncthreads(); sd[tid] += v; __syncthreads(); }
    const double excl = sd[tid] - loc;
    if ((tid & 7) == 0) sbase[tid >> 3] = excl + (double)lf[(size_t)(32 * tid) * 8 + a];
    __syncthreads();
    const double bs = sbase[tid >> 3]; double run = excl;
    float* frel = wsp<float>(F, WS_FREL) + (size_t)a * S; double* fd = wsp<double>(F, WS_FD) + (size_t)a * S;
    for (int i = 0; i < 32; ++i) { const int t = 32 * tid + i; run += (double)lf[(size_t)t * 8 + a]; fd[t] = run; frel[t] = (float)(run - bs); }
    if (tid < 64) { const double b_ = sbase[tid]; const float bh_ = (float)b_; wsp<f32x2>(F, WS_FBASE)[a * 64 + tid] = (f32x2){bh_, (float)(b_ - (double)bh_)}; }
    __syncthreads();
}

__device__ __forceinline__ void ld8(const bf16_t* p, float (&f)[8]) { const u32x4 w = *(const u32x4*)p; f[0] = bf_lo(w.x); f[1] = bf_hi(w.x); f[2] = bf_lo(w.y); f[3] = bf_hi(w.y); f[4] = bf_lo(w.z); f[5] = bf_hi(w.z); f[6] = bf_lo(w.w); f[7] = bf_hi(w.w); }
#if MK_NAIVE_ATTN
template <int MODE>
__device__ __forceinline__ void naive_attn_row(Frame& F, int l, int h, int t, float lamf, float laminit) {
    const int lane = F.lane, g = lane >> 4, i = lane & 15;
    const bf16_t* P = wsp<bf16_t>(F, WS_PROJ);
    const int qcol = (MODE == 0 ? QA : MODE == 1 ? QB_ : QC) + h * HD, kcol = (MODE == 0 ? KA : MODE == 1 ? KB_ : KC) + h * HD, vcol = (MODE == 0 ? VA : MODE == 1 ? VB_ : VC) + h * HD;
    float qf[8]; ld8(P + (size_t)t * NPROJ + qcol + 8 * i, qf);
    const int cq = t >> 6;
    const int s_lo = (MODE == 1) ? (cq >= 8 ? (cq - 8) * 64 : 0) : 0, s_hi = (MODE == 0) ? t : cq * 64 + 63;
    float m0 = -1e30f, l0 = 0.f, o0[8], m1 = -1e30f, l1 = 0.f, o1[8];
#pragma unroll
    for (int j = 0; j < 8; ++j) { o0[j] = 0.f; o1[j] = 0.f; }
    const double* fd = wsp<double>(F, WS_FD) + (size_t)h * S; const double ft = (MODE == 0) ? fd[t] : 0.0;
    const float* rb = FIN_rel_bias(F) + (size_t)(l * NHB + h) * 513;
#pragma unroll 2
    for (int s4 = s_lo; s4 <= s_hi; s4 += 4) {
        const int s = s4 + g; const bool valid = s <= s_hi; const int sc = valid ? s : s_hi;
        float kf[8], vf[8]; ld8(P + (size_t)sc * NPROJ + kcol + 8 * i, kf); ld8(P + (size_t)sc * NPROJ + vcol + 8 * i, vf);
        float d = 0.f;
#pragma unroll
        for (int j = 0; j < 8; ++j) d += qf[j] * kf[j];
        d += __shfl_xor(d, 1); d += __shfl_xor(d, 2); d += __shfl_xor(d, 4);
        if constexpr (MODE != 2) {
            d += __shfl_xor(d, 8);
            float bias;
            if constexpr (MODE == 0) bias = (float)(ft - fd[sc]) * LOG2E;
            else { int dd = t - sc; dd = dd < -256 ? -256 : (dd > 256 ? 256 : dd); bias = rb[dd + 256] * LOG2E; }
            const float sv = valid ? d + bias : -__builtin_inff();
            const float mn = fmaxf(m0, sv), al = __builtin_amdgcn_exp2f(m0 - mn), p = __builtin_amdgcn_exp2f(sv - mn);
            m0 = mn; l0 = l0 * al + p;
#pragma unroll
            for (int j = 0; j < 8; ++j) o0[j] = o0[j] * al + p * vf[j];
        } else {
            const float other = __shfl_xor(d, 8);
            const float sa = valid ? ((i < 8) ? d : other) : -__builtin_inff(), sb = valid ? ((i < 8) ? other : d) : -__builtin_inff();
            { const float mn = fmaxf(m0, sa), al = __builtin_amdgcn_exp2f(m0 - mn), p = __builtin_amdgcn_exp2f(sa - mn); m0 = mn; l0 = l0 * al + p;
#pragma unroll
              for (int j = 0; j < 8; ++j) o0[j] = o0[j] * al + p * vf[j]; }
            { const float mn = fmaxf(m1, sb), al = __builtin_amdgcn_exp2f(m1 - mn), p = __builtin_amdgcn_exp2f(sb - mn); m1 = mn; l1 = l1 * al + p;
#pragma unroll
              for (int j = 0; j < 8; ++j) o1[j] = o1[j] * al + p * vf[j]; }
        }
    }
#pragma unroll
    for (int sh = 16; sh < 64; sh <<= 1) {
        { const float m2 = __shfl_xor(m0, sh), l2 = __shfl_xor(l0, sh), mn = fmaxf(m0, m2), a = __builtin_amdgcn_exp2f(m0 - mn), b = __builtin_amdgcn_exp2f(m2 - mn);
          l0 = l0 * a + l2 * b; m0 = mn;
#pragma unroll
          for (int j = 0; j < 8; ++j) { const float o2 = __shfl_xor(o0[j], sh); o0[j] = o0[j] * a + o2 * b; } }
        if constexpr (MODE == 2) { const float m2 = __shfl_xor(m1, sh), l2 = __shfl_xor(l1, sh), mn = fmaxf(m1, m2), a = __builtin_amdgcn_exp2f(m1 - mn), b = __builtin_amdgcn_exp2f(m2 - mn);
          l1 = l1 * a + l2 * b; m1 = mn;
#pragma unroll
          for (int j = 0; j < 8; ++j) { const float o2 = __shfl_xor(o1[j], sh); o1[j] = o1[j] * a + o2 * b; } }
    }
    float r[8]; float ss = 0.f;
    const float il0 = 1.0f / l0, il1 = (MODE == 2) ? lamf / l1 : 0.f;
#pragma unroll
    for (int j = 0; j < 8; ++j) { r[j] = o0[j] * il0 - ((MODE == 2) ? o1[j] * il1 : 0.f); ss += r[j] * r[j]; }
    ss += __shfl_xor(ss, 1); ss += __shfl_xor(ss, 2); ss += __shfl_xor(ss, 4); ss += __shfl_xor(ss, 8);
    const float rstd = rsqrtf(ss * (1.0f / HD) + EPS) * ((MODE == 2) ? (1.0f - laminit) : 1.0f);
    const float* on = FIN_onorm(F) + (size_t)(l * 3 + MODE) * HD + 8 * i;
    if (g == 0) { const int ocol = (MODE == 0 ? 0 : MODE == 1 ? 768 : 1536) + h * HD + 8 * i;
        u32x4 w; w.x = cvt_pk_bf16(r[0] * rstd * on[0], r[1] * rstd * on[1]); w.y = cvt_pk_bf16(r[2] * rstd * on[2], r[3] * rstd * on[3]);
        w.z = cvt_pk_bf16(r[4] * rstd * on[4], r[5] * rstd * on[5]); w.w = cvt_pk_bf16(r[6] * rstd * on[6], r[7] * rstd * on[7]);
        *(u32x4*)(wsp<bf16_t>(F, WS_O) + (size_t)t * D + ocol) = w; }
}
__device__ __forceinline__ void naive_attn_phase(Frame& F, int l) {
    const int gw = F.vcu * 8 + F.wave, NGW = F.G * 8, lane = F.lane;
    const float laminit = 0.8f - 0.6f * expf(-0.3f * (float)l);
    const float* lm = FIN_lam(F) + l * 4 * 64;
    const float sa = wave_sum(lm[lane] * lm[64 + lane]), sb = wave_sum(lm[128 + lane] * lm[192 + lane]);
    const float lamf = expf(sa) - expf(sb) + laminit;
    for (int it = gw; it < S * 16; it += NGW) { const int t = it >> 4, hh = it & 15;
        if (hh < 6) naive_attn_row<0>(F, l, hh, t, lamf, laminit);
        else if (hh < 12) naive_attn_row<1>(F, l, hh - 6, t, lamf, laminit);
        else naive_attn_row<2>(F, l, hh - 12, t, lamf, laminit); }
}


#endif
namespace fa {
typedef float f32x16 __attribute__((ext_vector_type(16)));
typedef short s16x4 __attribute__((ext_vector_type(4)));
constexpr int SHM_V = 16384, SHM_K = 16384;
constexpr int NBUF = 3;
constexpr int OFF_V = 0, OFF_K = NBUF * SHM_V, OFF_WS = OFF_K + NBUF * SHM_K, OFF_BA = OFF_WS + 2048, OFF_TB = OFF_BA + NBUF * 256, ATT_LDS = OFF_TB + 2064;
constexpr float THR = 8.f;
constexpr float THR2 = MK_PV8 ? 2.f : 8.f;
constexpr float PSH = 3.f;
constexpr float SP8 = 64.f, SV8 = 16.f;
#define KSWZ(row, colB) ((row) * 256 + ((colB) ^ (((row) & 7) << 4)))
#define SBAR() __builtin_amdgcn_sched_barrier(0)
__device__ __forceinline__ int v_st(int k, int c) { const int kk = (k & ~0xC) | ((k & 4) << 1) | ((k & 8) >> 1); return ((kk >> 3) * 4 + (c >> 5)) * 512 + ((kk & 7) * 32 + (c & 31)) * 2; }
__device__ __forceinline__ int v_rd_base(int lane) { return ((lane & 3) << 3) | (((lane >> 2) & 3) << 6) | (((lane >> 4) & 1) << 5) | (((lane >> 5) & 1) << 8); }
constexpr int v_rd_off(int d0, int ks, int half) { return d0 * 512 + ks * 4096 + half * 2048; }
__device__ __forceinline__ int crow(int r, int hi) { return (r & 3) + 8 * (r >> 2) + 4 * hi; }
__device__ __forceinline__ unsigned cvtpk(float lo, float hi) { unsigned r; asm volatile("v_cvt_pk_bf16_f32 %0, %1, %2" : "=v"(r) : "v"(lo), "v"(hi)); return r; }
__device__ __forceinline__ void mask_causal(f32x16& p0, f32x16& p1, int dq) {
    const float NEG = -__builtin_inff();
#pragma unroll
    for (int r = 0; r < 16; ++r) { const int c = (r & 3) + 8 * (r >> 2); if (dq - c < 0) p0[r] = NEG; if (dq - c - 32 < 0) p1[r] = NEG; }
}
__device__ __forceinline__ void partialSM(f32x16& p0, f32x16& p1, float& m_reg, float& mn, float& alpha) {
    float pmax = p0[0];
#pragma unroll
    for (int r = 1; r < 16; ++r) pmax = fmaxf(pmax, p0[r]);
#pragma unroll
    for (int r = 0; r < 16; ++r) pmax = fmaxf(pmax, p1[r]);
    { auto rr = __builtin_amdgcn_permlane32_swap(__float_as_uint(pmax), __float_as_uint(pmax), false, false); pmax = fmaxf(__uint_as_float(rr[0]), __uint_as_float(rr[1])); }
    if (__builtin_expect(__all((pmax - m_reg) <= THR), 1)) { mn = m_reg; alpha = 1.f; }
    else { mn = fmaxf(m_reg, pmax); alpha = __builtin_amdgcn_exp2f(m_reg - mn); m_reg = mn; }
#pragma unroll
    for (int r = 0; r < 16; ++r) p0[r] = p0[r] - mn;
#pragma unroll
    for (int r = 0; r < 16; ++r) p1[r] = p1[r] - mn;
#pragma unroll
    for (int r = 0; r < 16; ++r) p0[r] = __builtin_amdgcn_exp2f(p0[r]);
}
__device__ __forceinline__ void partialSM_rel(f32x16& p0, f32x16& p1, float& m_reg, float& alpha, f32x16& negm) {
    float pmax = p0[0];
#pragma unroll
    for (int r = 1; r < 16; ++r) pmax = fmaxf(pmax, p0[r]);
#pragma unroll
    for (int r = 0; r < 16; ++r) pmax = fmaxf(pmax, p1[r]);
    { auto rr = __builtin_amdgcn_permlane32_swap(__float_as_uint(pmax), __float_as_uint(pmax), false, false); pmax = fmaxf(__uint_as_float(rr[0]), __uint_as_float(rr[1])); }
    if (__builtin_expect(__all(pmax <= THR2), 1)) { alpha = 1.f; }
    else { const float d = fmaxf(pmax, 0.f); m_reg += d; alpha = __builtin_amdgcn_exp2f(-d);
#pragma unroll
        for (int r = 0; r < 16; ++r) { p0[r] -= d; p1[r] -= d; }
#pragma unroll
        for (int r = 0; r < 16; ++r) negm[r] = -m_reg;
        asm volatile("" : "+v"(negm)); }
#pragma unroll
    for (int r = 0; r < 16; ++r) p0[r] = __builtin_amdgcn_exp2f(p0[r]);
}
__device__ __forceinline__ void finishSM(f32x16& p0, f32x16& p1, float alpha, float& l_reg, bf16x8& pa0, bf16x8& pa1, bf16x8& pa2, bf16x8& pa3) {
#pragma unroll
    for (int r = 0; r < 16; ++r) p1[r] = __builtin_amdgcn_exp2f(p1[r]);
    float ps = 0;
#pragma unroll
    for (int r = 0; r < 16; ++r) ps += p0[r];
#pragma unroll
    for (int r = 0; r < 16; ++r) ps += p1[r];
    { auto rr = __builtin_amdgcn_permlane32_swap(__float_as_uint(ps), __float_as_uint(ps), false, false); ps = __uint_as_float(rr[0]) + __uint_as_float(rr[1]); }
    l_reg = l_reg * alpha + ps;
#define PK4(P, B_, OUT) do { unsigned a0 = cvtpk(P[B_+0], P[B_+1]), a1 = cvtpk(P[B_+2], P[B_+3]); unsigned b0 = cvtpk(P[B_+4], P[B_+5]), b1 = cvtpk(P[B_+6], P[B_+7]); \
        auto r0 = __builtin_amdgcn_permlane32_swap(a0, b0, false, false); auto r1 = __builtin_amdgcn_permlane32_swap(a1, b1, false, false); \
        u32x4 w = {r0[0], r1[0], r0[1], r1[1]}; OUT = *reinterpret_cast<bf16x8*>(&w); } while (0)
    PK4(p0, 0, pa0); PK4(p0, 8, pa1); PK4(p1, 0, pa2); PK4(p1, 8, pa3);
#undef PK4
}
__device__ __forceinline__ void finishSM8(f32x16& p0, f32x16& p1, float alpha, float& l_reg, i32x8& p8) {
#pragma unroll
    for (int r = 0; r < 16; ++r) p1[r] = __builtin_amdgcn_exp2f(p1[r]);
    float ps = 0;
#pragma unroll
    for (int r = 0; r < 16; ++r) ps += p0[r];
#pragma unroll
    for (int r = 0; r < 16; ++r) ps += p1[r];
    { auto rr = __builtin_amdgcn_permlane32_swap(__float_as_uint(ps), __float_as_uint(ps), false, false); ps = __uint_as_float(rr[0]) + __uint_as_float(rr[1]); }
    l_reg = l_reg * alpha + ps;
#pragma unroll
    for (int d = 0; d < 4; ++d) { int w = 0; w = __builtin_amdgcn_cvt_pk_fp8_f32(p0[4 * d] * SP8, p0[4 * d + 1] * SP8, w, false); w = __builtin_amdgcn_cvt_pk_fp8_f32(p0[4 * d + 2] * SP8, p0[4 * d + 3] * SP8, w, true); p8[d] = w;
        int x = 0; x = __builtin_amdgcn_cvt_pk_fp8_f32(p1[4 * d] * SP8, p1[4 * d + 1] * SP8, x, false); x = __builtin_amdgcn_cvt_pk_fp8_f32(p1[4 * d + 2] * SP8, p1[4 * d + 3] * SP8, x, true); p8[4 + d] = x; }
}
__device__ __forceinline__ void partialSM_first8(f32x16& p0, f32x16& p1, float& m_reg) {
    float pmax = p0[0];
#pragma unroll
    for (int r = 1; r < 16; ++r) pmax = fmaxf(pmax, p0[r]);
#pragma unroll
    for (int r = 0; r < 16; ++r) pmax = fmaxf(pmax, p1[r]);
    { auto rr = __builtin_amdgcn_permlane32_swap(__float_as_uint(pmax), __float_as_uint(pmax), false, false); pmax = fmaxf(__uint_as_float(rr[0]), __uint_as_float(rr[1])); }
    m_reg = pmax - PSH;
#pragma unroll
    for (int r = 0; r < 16; ++r) { p0[r] -= m_reg; p1[r] -= m_reg; }
#pragma unroll
    for (int r = 0; r < 16; ++r) p0[r] = __builtin_amdgcn_exp2f(p0[r]);
}
__device__ __forceinline__ void partialSM_rel8(f32x16& p0, f32x16& p1, float& m_reg, float& alpha, f32x16& negm) {
    float pmax = p0[0];
#pragma unroll
    for (int r = 1; r < 16; ++r) pmax = fmaxf(pmax, p0[r]);
#pragma unroll
    for (int r = 0; r < 16; ++r) pmax = fmaxf(pmax, p1[r]);
    { auto rr = __builtin_amdgcn_permlane32_swap(__float_as_uint(pmax), __float_as_uint(pmax), false, false); pmax = fmaxf(__uint_as_float(rr[0]), __uint_as_float(rr[1])); }
    if (__builtin_expect(__all(pmax <= 8.f), 1)) { alpha = 1.f; }
    else { const float d = pmax > 8.f ? pmax - PSH : 0.f; m_reg += d; alpha = __builtin_amdgcn_exp2f(-d);
#pragma unroll
        for (int r = 0; r < 16; ++r) { p0[r] -= d; p1[r] -= d; }
#pragma unroll
        for (int r = 0; r < 16; ++r) negm[r] = -m_reg;
        asm volatile("" : "+v"(negm)); }
#pragma unroll
    for (int r = 0; r < 16; ++r) p0[r] = __builtin_amdgcn_exp2f(p0[r]);
}
__device__ __forceinline__ void finishLS8(f32x16& p0, f32x16& p1, i32x8& p8) {
#pragma unroll
    for (int r = 0; r < 16; ++r) p1[r] = __builtin_amdgcn_exp2f(p1[r]);
#pragma unroll
    for (int d = 0; d < 4; ++d) { int w = 0; w = __builtin_amdgcn_cvt_pk_fp8_f32(p0[4 * d], p0[4 * d + 1], w, false); w = __builtin_amdgcn_cvt_pk_fp8_f32(p0[4 * d + 2], p0[4 * d + 3], w, true); p8[d] = w;
        int x = 0; x = __builtin_amdgcn_cvt_pk_fp8_f32(p1[4 * d], p1[4 * d + 1], x, false); x = __builtin_amdgcn_cvt_pk_fp8_f32(p1[4 * d + 2], p1[4 * d + 3], x, true); p8[4 + d] = x; }
}
__device__ __forceinline__ void cvt16(const f32x16& p0, const f32x16& p1, i32x8& p8) {
#pragma unroll
    for (int d = 0; d < 4; ++d) { int w = p8[d]; w = __builtin_amdgcn_cvt_pk_fp8_f32(p0[4 * d], p0[4 * d + 1], w, false); w = __builtin_amdgcn_cvt_pk_fp8_f32(p0[4 * d + 2], p0[4 * d + 3], w, true); p8[d] = w;
        int x = p8[4 + d]; x = __builtin_amdgcn_cvt_pk_fp8_f32(p1[4 * d], p1[4 * d + 1], x, false); x = __builtin_amdgcn_cvt_pk_fp8_f32(p1[4 * d + 2], p1[4 * d + 3], x, true); p8[4 + d] = x; }
}
__device__ __forceinline__ float max16(const f32x16& p) {
    float m = fmaxf(p[0], p[1]);
#pragma unroll
    for (int r = 2; r < 16; r += 2) m = fmaxf(fmaxf(m, p[r]), p[r + 1]);
    return m;
}
__device__ __forceinline__ void pv8(f32x16* o, LAS const char* vb, const i32x8& p8, bool act) {
    if (!act) return;
#pragma unroll
    for (int d0 = 0; d0 < 4; ++d0) { i32x8 v8; v8.lo = *(LAS const i32x4*)(vb + d0 * 2560); v8.hi = *(LAS const i32x4*)(vb + d0 * 2560 + 16);
        o[d0] = __builtin_amdgcn_mfma_scale_f32_32x32x64_f8f6f4(p8, v8, o[d0], 0, 0, 0, 0, 0, 0); }
}
__device__ __forceinline__ void pv_tile(f32x16* o, int vb0, bf16x8 pa0, bf16x8 pa1, bf16x8 pa2, bf16x8 pa3, bool act) {
    if (!act) return;
#define TRRD(dst, off) asm volatile("ds_read_b64_tr_b16 %0, %1 offset:%2" : "=&v"(dst) : "v"(vb0), "i"(off) : "memory")
#define PV_D0(d0) do { s16x4 l0, l1, l2, l3, h0, h1, h2, h3; constexpr int b_ = v_rd_off(d0, 0, 0); \
        TRRD(l0, b_); TRRD(h0, b_ + 2048); TRRD(l1, b_ + 4096); TRRD(h1, b_ + 6144); TRRD(l2, b_ + 8192); TRRD(h2, b_ + 10240); TRRD(l3, b_ + 12288); TRRD(h3, b_ + 14336); \
        asm volatile("s_waitcnt lgkmcnt(0)" ::: "memory"); SBAR(); \
        o[d0] = __builtin_amdgcn_mfma_f32_32x32x16_bf16(pa0, (bf16x8){l0[0], l0[1], l0[2], l0[3], h0[0], h0[1], h0[2], h0[3]}, o[d0], 0, 0, 0); \
        o[d0] = __builtin_amdgcn_mfma_f32_32x32x16_bf16(pa1, (bf16x8){l1[0], l1[1], l1[2], l1[3], h1[0], h1[1], h1[2], h1[3]}, o[d0], 0, 0, 0); \
        o[d0] = __builtin_amdgcn_mfma_f32_32x32x16_bf16(pa2, (bf16x8){l2[0], l2[1], l2[2], l2[3], h2[0], h2[1], h2[2], h2[3]}, o[d0], 0, 0, 0); \
        o[d0] = __builtin_amdgcn_mfma_f32_32x32x16_bf16(pa3, (bf16x8){l3[0], l3[1], l3[2], l3[3], h3[0], h3[1], h3[2], h3[3]}, o[d0], 0, 0, 0); } while (0)
    PV_D0(0); PV_D0(1); PV_D0(2); PV_D0(3);
#undef PV_D0
#undef TRRD
}

struct BlockArgs {
    const bf16_t* Q; const bf16_t* K; const bf16_t* V;
    bf16_t* O;
    int qb;
    const float* frel; const f32x2* fbase;
    float* cst;
    const unsigned char* Q8; const unsigned char* K8;
    const unsigned char* VT;
    const float* cst2; unsigned* cmb; const float* lam;
    int map;
    int jlo0;
    float onscale; const float* onorm;
};

template <int MODE>
__device__ __forceinline__ void attn_block(LAS char* lds, const BlockArgs& B, int wave_) {
    const int MAP = (MODE == 2) ? B.map : 0;
    constexpr int ND = (MODE == 2) ? 4 : 8;
    constexpr bool SK = MODE != 0;
    const int tid = launder_tid(wave_), wid = wave_, lane = tid & 63, r32 = lane & 31, hi = lane >> 5;
    const int qb = B.qb, P0 = qb * 256;
    const int j_lo = (MODE == 1) ? (qb >= 2 ? 4 * qb - 8 : 0) : (MODE == 0) ? B.jlo0 : 0;
    const int NT = 4 * qb + 4 - j_lo;
    const int qlo = P0 + wid * 32, qm = qlo + r32 - 4 * hi, cq = 4 * qb + (wid >> 1);
    LAS char* V_lds = lds + OFF_V; LAS char* K_lds = lds + OFF_K;
    LAS float* ws = (LAS float*)(lds + OFF_WS) + wid * 64; LAS float* li_l = ws; LAS float* al_l = ws + 32;
    LAS float* ba = (LAS float*)(lds + OFF_BA); LAS float* tb = (LAS float*)(lds + OFF_TB);
    constexpr bool LS8 = MODE == 2 && MK_PV8 && MK_LS8;
    float m_reg = -1e30f, l_reg = 0; f32x16 o[LS8 ? 5 : 4]; f32x16 negm;
    { float z_ = 0.f; asm volatile("" : "+v"(z_));
#pragma unroll
      for (int r = 0; r < 16; ++r) { o[0][r] = z_; o[1][r] = z_; o[2][r] = z_; o[3][r] = z_; negm[r] = z_; if constexpr (LS8) o[4][r] = z_; } }
    i32x8 ones8; if constexpr (LS8) { int one_ = 0x38383838; asm volatile("" : "+v"(one_));
#pragma unroll
        for (int j = 0; j < 8; ++j) ones8[j] = one_; }
    const int sr = tid >> 4, sc = (tid & 15) * 8, vst0 = v_st(sr, sc), vst1 = v_st(32 + sr, sc), kws = KSWZ(sr, sc * 2);
    const int vb0 = (int)(unsigned)(uintptr_t)lds + v_rd_base(lane);
    const bf16_t* Kh = B.K; const bf16_t* Vh = B.V;
    bf16x8 st_v0, st_v1, st_k0, st_k1; float st_b = 0.f;
    constexpr bool QKAB = MODE != 2 && MK_QK8AB;
    const int kabst = (tid >> 3) * 144 + 16 * (tid & 7); LAS const char* kbab = K_lds + r32 * 144 + 32 * hi;
    constexpr bool PV8 = MODE == 2 && MK_PV8, KH = MODE == 2 && MK_KHALF, QK8 = MODE == 2 && MK_QK8;
    u32x2 st_k8; const int k8st = (tid >> 3) * 80 + 8 * (tid & 7);
    LAS const char* kb8 = K_lds + r32 * 80 + 32 * hi;
    const int kws2 = KSWZ(tid >> 3, (tid & 7) * 16) + MAP * 128, v8st = (tid >> 2) * 80 + 16 * (tid & 3);
    const bf16_t* Kh2 = Kh + (size_t)(tid >> 3) * NPROJ + 64 * MAP + (tid & 7) * 8;
    i32x8 p8; LAS const char* vb8 = V_lds + r32 * 80 + 32 * hi;
    if constexpr (MODE == 2 && MK_PV8) { int z8_ = 0; asm volatile("" : "+v"(z8_));
#pragma unroll
        for (int j = 0; j < 8; ++j) p8[j] = z8_; }
    f32x2 fbq = {0.f, 0.f}; if (MODE == 0) fbq = B.fbase[qb];
#define KBASE(t) ((j_lo + (t)) * 64)
#define ACT(t) ((MODE == 0) ? true : (MODE == 1) ? ((j_lo + (t)) + 8 >= cq && (j_lo + (t)) <= cq) : ((j_lo + (t)) <= cq))
#define ROWP(p, k0, rr) ((p) + (size_t)((k0) + (rr)) * NPROJ + sc)
#define VMW() asm volatile("s_waitcnt vmcnt(0)" ::: "memory")
#define SLOAD_H(t) do { const int k0_ = KBASE(t); if constexpr (PV8) st_v0 = *(const bf16x8*)(B.VT + (size_t)(j_lo + (t)) * 8192 + (unsigned)(tid * 16)); else { st_v0 = *(const bf16x8*)ROWP(Vh, k0_, sr); st_v1 = *(const bf16x8*)ROWP(Vh, k0_, 32 + sr); } \
        if constexpr (QK8) st_k8 = *(const u32x2*)(B.K8 + (size_t)k0_ * 64 + (unsigned)(tid * 8)); else if constexpr (KH) st_k0 = *(const bf16x8*)(Kh2 + (size_t)k0_ * NPROJ); else if constexpr (QKAB) st_k0 = *(const bf16x8*)(B.K8 + (size_t)k0_ * 128 + (unsigned)(tid * 16)); else { st_k0 = *(const bf16x8*)ROWP(Kh, k0_, sr); st_k1 = *(const bf16x8*)ROWP(Kh, k0_, 32 + sr); } if (MODE == 0 && tid < 64) st_b = B.frel[k0_ + tid]; } while (0)
#define SWRITE_HK(bf, t) do { if constexpr (QK8) *(LAS u32x2*)(K_lds + (bf) * SHM_K + k8st) = st_k8; else if constexpr (KH) *(LAS bf16x8*)(K_lds + (bf) * SHM_K + kws2) = st_k0; else if constexpr (QKAB) *(LAS bf16x8*)(K_lds + (bf) * SHM_K + kabst) = st_k0; else { *(LAS bf16x8*)(K_lds + (bf) * SHM_K + kws) = st_k0; *(LAS bf16x8*)(K_lds + (bf) * SHM_K + kws + 32 * 256) = st_k1; } \
        if (MODE == 0 && tid < 64) { const f32x2 fk_ = B.fbase[(j_lo + (t)) >> 2]; const float cst_ = (fbq.x - fk_.x) + (fbq.y - fk_.y); ba[(bf) * 64 + tid] = (cst_ - st_b) * LOG2E; } } while (0)
#define SWRITE_HV(bf) do { if constexpr (PV8) *(LAS bf16x8*)(V_lds + (bf) * SHM_V + v8st) = st_v0; else { *(LAS bf16x8*)(V_lds + (bf) * SHM_V + vst0) = st_v0; *(LAS bf16x8*)(V_lds + (bf) * SHM_V + vst1) = st_v1; } } while (0)
#define FIN(P0_, P1_, al_) do { if constexpr (LS8) finishLS8(P0_, P1_, p8); else if constexpr (PV8) finishSM8(P0_, P1_, al_, l_reg, p8); else finishSM(P0_, P1_, al_, l_reg, pa0, pa1, pa2, pa3); } while (0)
#define PVT(act_) do { if constexpr (LS8) { if (act_) { pv8(o, vb8 + bp * SHM_V, p8, true); o[4] = __builtin_amdgcn_mfma_scale_f32_32x32x64_f8f6f4(p8, ones8, o[4], 0, 0, 0, 0, 0, 0); } } else if constexpr (PV8) pv8(o, vb8 + bp * SHM_V, p8, act_); else pv_tile(o, vb0 + bp * SHM_V, pa0, pa1, pa2, pa3, act_); } while (0)
#define SWRITE_H(bf, t) do { SWRITE_HV(bf); SWRITE_HK(bf, t); } while (0)
#define RESC(a) do { if (__any((a) < 1.f)) { if (hi == 0) al_l[r32] = (a); asm volatile("s_waitcnt lgkmcnt(0)" ::: "memory"); \
        _Pragma("unroll") for (int d_ = 0; d_ < (LS8 ? 5 : 4); ++d_) _Pragma("unroll") for (int r = 0; r < 16; ++r) o[d_][r] *= al_l[crow(r, hi)]; } } while (0)
#define MASKT(P0_, P1_, t) do { if (MODE == 0) { const int kb_ = KBASE(t); if (kb_ + 63 > qlo) mask_causal(P0_, P1_, qm - kb_); } } while (0)
#define QKT(KB, PX0, PX1, t) do { const bool act_ = ACT(t); \
        if (SK && !act_) { const float NEG = -__builtin_inff(); _Pragma("unroll") for (int r = 0; r < 16; ++r) { PX0[r] = NEG; PX1[r] = NEG; } } \
        else { \
            if (MODE == 0) { _Pragma("unroll") for (int j = 0; j < 4; ++j) { const f32x4 b0_ = *(const LAS f32x4*)(ba + (KB) * 64 + 8 * j + 4 * hi), b1_ = *(const LAS f32x4*)(ba + (KB) * 64 + 32 + 8 * j + 4 * hi); \
                    _Pragma("unroll") for (int q = 0; q < 4; ++q) { PX0[4 * j + q] = b0_[q]; PX1[4 * j + q] = b1_[q]; } } } \
            else if (MODE == 1) { const int dq_ = qm - KBASE(t); _Pragma("unroll") for (int r = 0; r < 16; ++r) { const int c_ = (r & 3) + 8 * (r >> 2); \
                    int i0_ = dq_ - c_, i1_ = dq_ - c_ - 32; i0_ = i0_ < -256 ? -256 : (i0_ > 256 ? 256 : i0_); i1_ = i1_ < -256 ? -256 : (i1_ > 256 ? 256 : i1_); PX0[r] = tb[i0_ + 256]; PX1[r] = tb[i1_ + 256]; } } \
            else { } \
            LAS const char* kb_[4]; _Pragma("unroll") for (int dd = 0; dd < 4; ++dd) kb_[dd] = K_lds + (KB) * SHM_K + KSWZ(r32, (dd * 16 + hi * 8) * 2); \
            if constexpr (QKAB) { i32x8 k0a_, k0b_, k1a_, k1b_; LAS const char* a_ = kbab + (KB) * SHM_K;      \
                k0a_.lo = *(LAS const i32x4*)a_; k0a_.hi = *(LAS const i32x4*)(a_ + 16); k0b_.lo = *(LAS const i32x4*)(a_ + 64); k0b_.hi = *(LAS const i32x4*)(a_ + 80); \
                k1a_.lo = *(LAS const i32x4*)(a_ + 4608); k1a_.hi = *(LAS const i32x4*)(a_ + 4624); k1b_.lo = *(LAS const i32x4*)(a_ + 4672); k1b_.hi = *(LAS const i32x4*)(a_ + 4688); \
                PX0 = __builtin_amdgcn_mfma_scale_f32_32x32x64_f8f6f4(k0a_, q8, PX0, 0, 0, 0, 0, 0, 0); PX1 = __builtin_amdgcn_mfma_scale_f32_32x32x64_f8f6f4(k1a_, q8, PX1, 0, 0, 0, 0, 0, 0); \
                PX0 = __builtin_amdgcn_mfma_scale_f32_32x32x64_f8f6f4(k0b_, q8b, PX0, 0, 0, 0, 0, 0, 0); PX1 = __builtin_amdgcn_mfma_scale_f32_32x32x64_f8f6f4(k1b_, q8b, PX1, 0, 0, 0, 0, 0, 0); } \
            else if constexpr (QK8) { i32x8 ka_, kc_; LAS const char* a_ = kb8 + (KB) * SHM_K; ka_.lo = *(LAS const i32x4*)a_; ka_.hi = *(LAS const i32x4*)(a_ + 16); kc_.lo = *(LAS const i32x4*)(a_ + 2560); kc_.hi = *(LAS const i32x4*)(a_ + 2576); \
                PX0 = __builtin_amdgcn_mfma_scale_f32_32x32x64_f8f6f4(ka_, q8, negm, 0, 0, 0, 0, 0, 0); PX1 = __builtin_amdgcn_mfma_scale_f32_32x32x64_f8f6f4(kc_, q8, negm, 0, 0, 0, 0, 0, 0); } \
            else if constexpr (MODE == 2) { bf16x8 kf0_[4], kf1_[4];     \
                _Pragma("unroll") for (int d0 = 0; d0 < 4; ++d0) { LAS const char* a_ = kb_[d0] + MAP * 128; kf0_[d0] = *(LAS const bf16x8*)a_; kf1_[d0] = *(LAS const bf16x8*)(a_ + 32 * 256); } \
                PX0 = __builtin_amdgcn_mfma_f32_32x32x16_bf16(kf0_[0], qr[0], negm, 0, 0, 0); PX1 = __builtin_amdgcn_mfma_f32_32x32x16_bf16(kf1_[0], qr[0], negm, 0, 0, 0); \
                _Pragma("unroll") for (int d0 = 1; d0 < 4; ++d0) { PX0 = __builtin_amdgcn_mfma_f32_32x32x16_bf16(kf0_[d0], qr[d0], PX0, 0, 0, 0); PX1 = __builtin_amdgcn_mfma_f32_32x32x16_bf16(kf1_[d0], qr[d0], PX1, 0, 0, 0); } } \
            else { _Pragma("unroll") for (int d0 = 0; d0 < ND; ++d0) { LAS const char* a_ = kb_[d0 & 3] + (d0 >> 2) * 128; \
                const bf16x8 b0_ = *(LAS const bf16x8*)a_, b1_ = *(LAS const bf16x8*)(a_ + 32 * 256); \
                PX0 = __builtin_amdgcn_mfma_f32_32x32x16_bf16(b0_, qr[d0], PX0, 0, 0, 0); PX1 = __builtin_amdgcn_mfma_f32_32x32x16_bf16(b1_, qr[d0], PX1, 0, 0, 0); } } } } while (0)
    bf16x8 qr[ND]; i32x8 q8, q8b;
    if constexpr (QKAB) { const unsigned char* qp_ = B.Q8 + (size_t)(wid * 32 + r32) * 128 + 32 * hi; q8.lo = *(const i32x4*)qp_; q8.hi = *(const i32x4*)(qp_ + 16); q8b.lo = *(const i32x4*)(qp_ + 64); q8b.hi = *(const i32x4*)(qp_ + 80); }
    else if constexpr (QK8) { const unsigned char* qp_ = B.Q8 + (size_t)(wid * 32 + r32) * 64 + 32 * hi; q8.lo = *(const i32x4*)qp_; q8.hi = *(const i32x4*)(qp_ + 16); }
    else
#pragma unroll
    for (int d0 = 0; d0 < ND; ++d0) qr[d0] = *(const bf16x8*)(B.Q + (size_t)(wid * 32 + r32) * NPROJ + ((MODE == 2) ? 64 * MAP : 0) + d0 * 16 + hi * 8);
    SLOAD_H(0); VMW(); SWRITE_H(0, 0);
    if (NT > 1) SLOAD_H(1);
    __syncthreads();
    f32x16 pA0, pA1, pB0, pB1; float mnA, mnB, alA, alB; bf16x8 pa0, pa1, pa2, pa3;
    SBAR(); QKT(0, pA0, pA1, 0);
    MASKT(pA0, pA1, 0); if constexpr (LS8) { partialSM_first8(pA0, pA1, m_reg); alA = 1.f; } else partialSM(pA0, pA1, m_reg, mnA, alA);
    if constexpr (MODE == 2) {
#pragma unroll
        for (int r = 0; r < 16; ++r) negm[r] = -m_reg;
        asm volatile("" : "+v"(negm)); }
    if (NT > 1) { VMW(); SWRITE_H(1, 1); }
    __syncthreads();
    int bp = 0, bc = 1, bn = 2;
#define STEP(PX0, PX1, mnX, alX, PY0, PY1, alY, t) do { \
        if ((t) + 1 < NT) { SLOAD_H((t) + 1); } \
        SBAR(); QKT(bc, PX0, PX1, t); \
        FIN(PY0, PY1, alY); SBAR(); \
        PVT(!SK || ACT((t) - 1)); MASKT(PX0, PX1, (t)); if constexpr (LS8) partialSM_rel8(PX0, PX1, m_reg, alX, negm); else if constexpr (MODE == 2) partialSM_rel(PX0, PX1, m_reg, alX, negm); else partialSM(PX0, PX1, m_reg, mnX, alX); \
        RESC(alX); \
        if ((t) + 1 < NT) { VMW(); SWRITE_H(bn, (t) + 1); } \
        __syncthreads(); \
        bp = bc; bc = bn; bn = (bn == NBUF - 1) ? 0 : bn + 1; } while (0)
#define MF8(a_, b_, c_) __builtin_amdgcn_mfma_scale_f32_32x32x64_f8f6f4(a_, b_, c_, 0, 0, 0, 0, 0, 0)
#define LD8(dst_, adr_) do { dst_.lo = *(LAS const i32x4*)(adr_); dst_.hi = *(LAS const i32x4*)((adr_) + 16); } while (0)
#define EXPR(P_, b_) _Pragma("unroll") for (int r_ = (b_); r_ < (b_) + 8; ++r_) P_[r_] = __builtin_amdgcn_exp2f(P_[r_])
#define STEPF(PX0, PX1, alX, PY0, PY1, t) do { \
        SLOAD_H((t) + 1); \
        i32x8 ka_, kc_, vx_, vy_; LAS const char* ak_ = kb8 + bc * SHM_K; LAS const char* av_ = vb8 + bp * SHM_V; \
        LD8(ka_, ak_); LD8(kc_, ak_ + 2560); LD8(vx_, av_); LD8(vy_, av_ + 2560); \
        EXPR(PY1, 0); SBAR(); \
        PX0 = MF8(ka_, q8, negm); EXPR(PY1, 8); SBAR(); \
        PX1 = MF8(kc_, q8, negm); cvt16(PY0, PY1, p8); SBAR(); \
        o[0] = MF8(p8, vx_, o[0]); LD8(vx_, av_ + 5120); float pm_ = max16(PX0); SBAR(); \
        o[1] = MF8(p8, vy_, o[1]); LD8(vy_, av_ + 7680); pm_ = fmaxf(pm_, max16(PX1)); \
        { auto rr_ = __builtin_amdgcn_permlane32_swap(__float_as_uint(pm_), __float_as_uint(pm_), false, false); pm_ = fmaxf(__uint_as_float(rr_[0]), __uint_as_float(rr_[1])); } SBAR(); \
        o[4] = MF8(p8, onesF, o[4]); EXPR(PX0, 0); SBAR(); \
        o[2] = MF8(p8, vx_, o[2]); EXPR(PX0, 8); SBAR(); \
        o[3] = MF8(p8, vy_, o[3]); VMW(); SWRITE_H(bn, (t) + 1); SBAR(); \
        alX = 1.f; \
        if (__builtin_expect(!__all(pm_ <= 8.f), 0)) { const float d_ = pm_ > 8.f ? pm_ - PSH : 0.f; m_reg += d_; alX = __builtin_amdgcn_exp2f(-d_); \
            _Pragma("unroll") for (int r = 0; r < 16; ++r) negm[r] = -m_reg; \
            asm volatile("" : "+v"(negm)); \
              \
            LD8(ka_, ak_); LD8(kc_, ak_ + 2560); PX0 = MF8(ka_, q8, negm); PX1 = MF8(kc_, q8, negm); EXPR(PX0, 0); EXPR(PX0, 8); } \
        RESC(alX); \
        __syncthreads(); \
        bp = bc; bc = bn; bn = (bn == NBUF - 1) ? 0 : bn + 1; } while (0)
    int t = 1;
    if constexpr (LS8 && QK8 && MK_STEPF) {
        i32x8 onesF; { int one_; asm volatile("v_mov_b32 %0, 0x38383838" : "=v"(one_));
#pragma unroll
            for (int j = 0; j < 8; ++j) onesF[j] = one_; }
        for (; t + 1 <= 4 * qb; t += 2) { STEPF(pB0, pB1, alB, pA0, pA1, t); STEPF(pA0, pA1, alA, pB0, pB1, t + 1); }
    }
    for (; t + 1 < NT; t += 2) {
        STEP(pB0, pB1, mnB, alB, pA0, pA1, alA, t);
        STEP(pA0, pA1, mnA, alA, pB0, pB1, alB, t + 1);
    }
    if (t < NT) {
        STEP(pB0, pB1, mnB, alB, pA0, pA1, alA, t);
        FIN(pB0, pB1, alB); SBAR();
    } else {
        FIN(pA0, pA1, alA); SBAR();
    }
    PVT(!SK || ACT(NT - 1));
    SBAR();
    if (!LS8) { if (hi == 0) li_l[r32] = l_reg; asm volatile("s_waitcnt lgkmcnt(0)" ::: "memory"); }
    float rli[16];
#pragma unroll
    for (int r = 0; r < 16; ++r) { if constexpr (LS8) rli[r] = __builtin_amdgcn_rcpf(o[4][r]) * (1.0f / SV8); else rli[r] = __builtin_amdgcn_rcpf(li_l[crow(r, hi)]) * (PV8 ? 1.0f / (SP8 * SV8) : 1.0f); }
#pragma unroll
    for (int d0 = 0; d0 < 4; ++d0)
#pragma unroll
        for (int r = 0; r < 16; ++r) o[d0][r] *= rli[r];
    bool fin = MODE != 2;
    if constexpr (MODE == 2) {
        float* cs = B.cst + wid * 4096 + lane;
#pragma unroll
        for (int r = 0; r < 16; ++r)
#pragma unroll
            for (int d0 = 0; d0 < 4; ++d0) cs[(r * 4 + d0) * 64] = o[d0][r];
        if constexpr (MK_CMB) {
            LAS unsigned* flag = (LAS unsigned*)(lds + OFF_WS);
            asm volatile("s_waitcnt vmcnt(0)" ::: "memory"); __syncthreads();
            if (wid == 0 && lane_now() == 0) { __builtin_amdgcn_fence(__ATOMIC_RELEASE, "agent"); asm volatile("s_waitcnt vmcnt(0)" ::: "memory");
                const unsigned old_ = __hip_atomic_fetch_add(B.cmb, 1u, __ATOMIC_RELAXED, __HIP_MEMORY_SCOPE_AGENT);
                if (old_ & 1u) { __builtin_amdgcn_fence(__ATOMIC_ACQUIRE, "agent"); asm volatile("s_waitcnt vmcnt(0)" ::: "memory"); }
                flag[0] = old_; }
            __syncthreads();
            fin = (__builtin_amdgcn_readfirstlane(flag[0]) & 1u) != 0;
            if (fin) {
                const float* lm = B.lam; const int ln = lane_now();
                float sa = lm[ln] * lm[64 + ln], sb = lm[128 + ln] * lm[192 + ln];
                sa += sxor<1>(sa); sa += sxor<2>(sa); sa += sxor<4>(sa); sa += sxor<8>(sa); sa += sxor<16>(sa); sb += sxor<1>(sb); sb += sxor<2>(sb); sb += sxor<4>(sb); sb += sxor<8>(sb); sb += sxor<16>(sb);
                { auto ra_ = __builtin_amdgcn_permlane32_swap(__float_as_uint(sa), __float_as_uint(sa), false, false); sa = __uint_as_float(ra_[0]) + __uint_as_float(ra_[1]);
                  auto rb_ = __builtin_amdgcn_permlane32_swap(__float_as_uint(sb), __float_as_uint(sb), false, false); sb = __uint_as_float(rb_[0]) + __uint_as_float(rb_[1]); }
                const float lamf = expf(sa) - expf(sb) + (1.0f - B.onscale);
                const bool m0_ = MAP == 0;
                const float* co = B.cst2 + wid * 4096 + lane;
#pragma unroll
                for (int r = 0; r < 16; ++r)
#pragma unroll
                    for (int d0 = 0; d0 < 4; ++d0) { const float own_ = o[d0][r], oth_ = co[(r * 4 + d0) * 64]; const float a_ = m0_ ? own_ : oth_, b_ = m0_ ? oth_ : own_; o[d0][r] = a_ - b_ * lamf; }
            }
        }
    }
    if (fin) {
        float on[4];
#pragma unroll
        for (int d0 = 0; d0 < 4; ++d0) on[d0] = B.onorm[d0 * 32 + r32] * B.onscale;
        bf16_t* Ow = B.O + (size_t)(wid * 32) * D;
#pragma unroll
        for (int r = 0; r < 16; ++r) {
            float ss = (o[0][r] * o[0][r] + o[1][r] * o[1][r]) + (o[2][r] * o[2][r] + o[3][r] * o[3][r]);
            ss += sxor<1>(ss); ss += sxor<2>(ss); ss += sxor<4>(ss); ss += sxor<8>(ss); ss += sxor<16>(ss);
            const float rs = rsqrtf(ss * (1.0f / HD) + EPS); const int orow = crow(r, hi);
#pragma unroll
            for (int d0 = 0; d0 < 4; ++d0) { const float v = o[d0][r] * rs * on[d0]; const float vn = sxor<1>(v);
                if ((r32 & 1) == 0) *(unsigned*)(Ow + (size_t)orow * D + d0 * 32 + r32) = cvtpk(v, vn); } }
    }
    __syncthreads();
#undef KBASE
#undef ACT
#undef ROWP
#undef VMW
#undef SLOAD_H
#undef SWRITE_HK
#undef SWRITE_HV
#undef STEPF
#undef MF8
#undef LD8
#undef EXPR
#undef FIN
#undef PVT
#undef SWRITE_H
#undef RESC
#undef MASKT
#undef QKT
#undef STEP
}
#undef KSWZ
#undef SBAR
}

constexpr int CW_PRE = 3072;
constexpr int CW_AQ = 2048;
constexpr int N_PRE = 70, N_ATT_ITEMS = 1280 + N_PRE + (MK_XCONV ? NCV : 0);
constexpr float TAU2 = 60.f;
__device__ __forceinline__ void prepass_item(Frame& F, int k) {
    const int lane = launder_tid(F.wave) & 63, i = lane & 15, g = lane >> 4;
    const bf16_t* P = wsp<bf16_t>(F, WS_PROJ);
    for (int it = k * 24 + F.wave * 3; it < k * 24 + F.wave * 3 + 3; ++it) { const int h = it >> 8, tl = it & 255; float qm = 0.f, km = 0.f;
#pragma unroll 4
        for (int rr = 0; rr < 16; ++rr) { const size_t row = (size_t)(tl * 64 + rr * 4 + g) * NPROJ; float qf[8], kf[8]; ld8(P + row + QA + h * HD + 8 * i, qf); ld8(P + row + KA + h * HD + 8 * i, kf);
            float sq = 0.f, sk = 0.f;
#pragma unroll
            for (int j = 0; j < 8; ++j) { sq += qf[j] * qf[j]; sk += kf[j] * kf[j]; }
            sq += sxor<1>(sq); sq += sxor<2>(sq); sq += sxor<4>(sq); sq += sxor<8>(sq);
            sk += sxor<1>(sk); sk += sxor<2>(sk); sk += sxor<4>(sk); sk += sxor<8>(sk);
            qm = fmaxf(qm, sq); km = fmaxf(km, sk); }
        qm = half_max(fmaxf(qm, sxor<16>(qm))); km = half_max(fmaxf(km, sxor<16>(km)));
        if (lane == 0) { wsp<float>(F, WS_QN)[it] = sqrtf(qm) * (MK_QK8AB ? 1.08f : 1.001f); wsp<float>(F, WS_KN)[it] = sqrtf(km) * (MK_QK8AB ? 1.08f : 1.001f); } }
}
__device__ __forceinline__ void attn_phase(Frame& F, int l, unsigned* ctl, volatile LAS unsigned* MISC) {
    const float laminit = 0.8f - 0.6f * expf(-0.3f * (float)l);
    const bf16_t* P = wsp<bf16_t>(F, WS_PROJ); bf16_t* Ob = wsp<bf16_t>(F, WS_O);
    LAS char* lds = (LAS char*)F.lds; bool pre_ok = false;
    for (;;) {
        { unsigned* qh_ = ctl + CW_AQ + 64 * l; asm volatile("" : "+s"(qh_));
          if (launder_tid(F.wave) == 0) MISC[16] = __hip_atomic_fetch_add(qh_, 1u, __ATOMIC_RELAXED, __HIP_MEMORY_SCOPE_AGENT); }
        __syncthreads();
        int it = (int)__builtin_amdgcn_readfirstlane(MISC[16]);
        __syncthreads();
        if (it >= ((MK_DUP & 8) ? 2 : 1) * N_ATT_ITEMS) break;
        if (it >= N_ATT_ITEMS) it -= N_ATT_ITEMS;
#if MK_XCONV
        if (it >= 256) {
            if (it < 512 + NCV) { const int p = it - 256, g = p / 9, j = p - 9 * g;
                if (j == 0) it = 256 + 2 * g; else if (j == 4) it = 257 + 2 * g;
                else { expert_conv_item(F, l * NCV + 7 * g + (j < 4 ? j - 1 : j - 2)); continue; } }
            else it -= NCV; }
#endif
        fa::BlockArgs B; B.onscale = 1.f; B.frel = nullptr; B.fbase = nullptr; B.cst = nullptr; B.jlo0 = 0; B.map = 0; B.cst2 = nullptr; B.cmb = nullptr; B.lam = nullptr; B.VT = nullptr; B.Q8 = nullptr; B.K8 = nullptr; B.onorm = nullptr; B.O = nullptr;
        if (it < 512) { const int qb = 63 - (it >> 3), h = it & 3, mp = (it >> 2) & 1; B.qb = qb;
            B.Q = P + (size_t)qb * 256 * NPROJ + QC + h * HD; B.K = P + KC + h * HD; B.V = P + VC + h * HD; B.VT = wsp<unsigned char>(F, WS_VT8) + (size_t)h * 256 * 128 * 64;
            B.Q8 = wsp<unsigned char>(F, WS_Q8) + ((size_t)(h * 2 + mp) * S + qb * 256) * 64; B.K8 = wsp<unsigned char>(F, WS_K8) + (size_t)(h * 2 + mp) * S * 64;
            B.cst = wsp<float>(F, WS_CST) + (size_t)((mp * 4 + h) * 64 + qb) * 32768; B.cst2 = wsp<float>(F, WS_CST) + (size_t)(((mp ^ 1) * 4 + h) * 64 + qb) * 32768;
            B.cmb = ctl + CW_CMB + 256 * l + 4 * qb + h; B.lam = FIN_lam(F) + l * 4 * 64; B.onscale = 1.0f - laminit; B.onorm = FIN_onorm(F) + (l * 3 + 2) * HD; B.O = Ob + (size_t)qb * 256 * D + 1536 + h * HD;
            B.map = mp; fa::attn_block<2>(lds, B, F.wave); }
        else if (it < 512 + N_PRE) { const int k = it - 512;
            if (k < 6) scan_head(F, k); else prepass_item(F, k - 6);
            asm volatile("s_waitcnt vmcnt(0)" ::: "memory"); __syncthreads();
            if (F.wave == 0 && lane_now() == 0) { __builtin_amdgcn_fence(__ATOMIC_RELEASE, "agent"); asm volatile("s_waitcnt vmcnt(0)" ::: "memory");
                __hip_atomic_fetch_add(ctl + CW_PRE + 64 * l, 1u, __ATOMIC_RELAXED, __HIP_MEMORY_SCOPE_AGENT); } }
        else if (it < 896 + N_PRE) { const int j = it - 512 - N_PRE, h = j % 6, qb = 63 - j / 6; B.qb = qb;
            B.Q = P + (size_t)qb * 256 * NPROJ + QB_ + h * HD; B.K = P + KB_ + h * HD; B.V = P + VB_ + h * HD; B.O = Ob + (size_t)qb * 256 * D + 768 + h * HD; B.onorm = FIN_onorm(F) + (l * 3 + 1) * HD;
            B.Q8 = wsp<unsigned char>(F, WS_Q8AB) + ((size_t)(6 + h) * S + qb * 256) * 128; B.K8 = wsp<unsigned char>(F, WS_K8AB) + (size_t)(6 + h) * S * 128;
            LAS float* tb = (LAS float*)(lds + fa::OFF_TB); const float* rb = FIN_rel_bias(F) + (size_t)(l * NHB + h) * 513;
            for (int i = launder_tid(F.wave); i < 513; i += 512) tb[i] = rb[i] * LOG2E;
            fa::attn_block<1>(lds, B, F.wave); }
        else { const int j = it - 896 - N_PRE, h = j % 6, qb = 63 - j / 6; B.qb = qb;
            B.Q = P + (size_t)qb * 256 * NPROJ + QA + h * HD; B.K = P + KA + h * HD; B.V = P + VA + h * HD; B.O = Ob + (size_t)qb * 256 * D + h * HD;
            B.Q8 = wsp<unsigned char>(F, WS_Q8AB) + ((size_t)h * S + qb * 256) * 128; B.K8 = wsp<unsigned char>(F, WS_K8AB) + (size_t)h * S * 128;
            B.frel = wsp<float>(F, WS_FREL) + (size_t)h * S; B.fbase = wsp<f32x2>(F, WS_FBASE) + h * 64; B.onorm = FIN_onorm(F) + (l * 3 + 0) * HD;
            if (!pre_ok) {
                if (F.wave == 0 && lane_now() == 0) { unsigned* pc_ = ctl + CW_PRE + 64 * l; unsigned sp_ = 0;
                    while (__hip_atomic_load(pc_, __ATOMIC_RELAXED, __HIP_MEMORY_SCOPE_AGENT) < (unsigned)N_PRE) { __builtin_amdgcn_s_sleep(2); if (++sp_ > (1u << 22)) { __hip_atomic_store(ctl + CW_TMO, 1u, __ATOMIC_RELAXED, __HIP_MEMORY_SCOPE_AGENT); break; } }
                    __builtin_amdgcn_fence(__ATOMIC_ACQUIRE, "agent"); asm volatile("s_waitcnt vmcnt(0)" ::: "memory"); }
                __syncthreads(); pre_ok = true; }
            const float* qn = wsp<float>(F, WS_QN) + h * 256; const float* kn = wsp<float>(F, WS_KN) + h * 256;
            const int lane = launder_tid(F.wave) & 63;
            float kmax = fmaxf(fmaxf(kn[lane], kn[64 + lane]), fmaxf(kn[128 + lane], kn[192 + lane]));
            kmax = wave_max(kmax);
            const float qmax = fmaxf(fmaxf(qn[4 * qb], qn[4 * qb + 1]), fmaxf(qn[4 * qb + 2], qn[4 * qb + 3]));
            const float nb = qmax * 2.f * kmax; const f32x2 fq = B.fbase[qb];
            int jl = 4 * qb;
#pragma unroll
            for (int c = 3; c >= 0; --c) { const int J = 64 * c + lane; bool keep = false;
                if (J < 4 * qb) { const f32x2 fk = B.fbase[J >> 2]; const float dF = (((fq.x - fk.x) + (fq.y - fk.y)) - B.frel[64 * J + 63]) * LOG2E; keep = !(nb + dF < -TAU2); }
                const unsigned long long mk = __ballot(keep); if (mk) jl = 64 * c + (int)__builtin_ctzll(mk); }
            B.jlo0 = __builtin_amdgcn_readfirstlane(jl);
            fa::attn_block<0>(lds, B, F.wave); }
    }
}
__device__ __forceinline__ void attn_combine(Frame& F, int l) {
    const int gw = F.vcu * 8 + F.wave, NGW = F.G * 8, lane = F.lane;
    const float laminit = 0.8f - 0.6f * expf(-0.3f * (float)l);
    const float* lm = FIN_lam(F) + l * 4 * 64;
    const float sa = wave_sum(lm[lane] * lm[64 + lane]), sb = wave_sum(lm[128 + lane] * lm[192 + lane]);
    const float lamf = expf(sa) - expf(sb) + laminit;
    const float* on = FIN_onorm(F) + (l * 3 + 2) * HD + 8 * (lane & 15);
    float g8[8];
#pragma unroll
    for (int j = 0; j < 8; ++j) g8[j] = on[j] * (1.0f - laminit);
    const float* c0 = wsp<float>(F, WS_CST); const float* c1 = c0 + (size_t)4 * 64 * 32768; bf16_t* Ob = wsp<bf16_t>(F, WS_O);
    const int hh = lane >> 4, i16 = lane & 15;
    for (int t = gw; t < S; t += NGW) {
        const int qb = t >> 8, wv = (t >> 5) & 7, row32 = t & 31, hi = (row32 >> 2) & 1, r = (row32 & 3) + 4 * (row32 >> 3);
        const size_t off = (size_t)(hh * 64 + qb) * 32768 + wv * 4096 + (r * 4 + (i16 >> 2)) * 64 + 32 * hi + 8 * (i16 & 3);
        const f32x4 a0 = *(const f32x4*)(c0 + off), a1 = *(const f32x4*)(c0 + off + 4);
        const f32x4 b0 = *(const f32x4*)(c1 + off), b1 = *(const f32x4*)(c1 + off + 4);
        const f32x4 r0 = a0 - b0 * lamf, r1 = a1 - b1 * lamf;
        float ss = (r0.x * r0.x + r0.y * r0.y) + (r0.z * r0.z + r0.w * r0.w) + (r1.x * r1.x + r1.y * r1.y) + (r1.z * r1.z + r1.w * r1.w);
        ss += sxor<1>(ss); ss += sxor<2>(ss); ss += sxor<4>(ss); ss += sxor<8>(ss);
        const float rs = rsqrtf(ss * (1.0f / HD) + EPS);
        u32x4 w; w.x = cvt_pk_bf16(r0.x * rs * g8[0], r0.y * rs * g8[1]); w.y = cvt_pk_bf16(r0.z * rs * g8[2], r0.w * rs * g8[3]);
        w.z = cvt_pk_bf16(r1.x * rs * g8[4], r1.y * rs * g8[5]); w.w = cvt_pk_bf16(r1.z * rs * g8[6], r1.w * rs * g8[7]);
        *(u32x4*)(Ob + (size_t)t * D + 1536 + 8 * lane) = w; }
}

__device__ __forceinline__ void sort_phase(Frame& F) {
    LAS int* cnt = (LAS int*)F.lds; LAS int* pre = cnt + 2048; LAS int* tot = pre + 2048; LAS int* base = tot + 8; LAS int* sl = base + 16;
    const unsigned* toke = wsp<unsigned>(F, WS_TOKE);
    const int lane = F.lane, wave = F.wave, tid = F.tid;
    for (int c = wave; c < 256; c += 8) { const unsigned pe = toke[c * 64 + lane]; const int e1 = pe & 0xff, e2 = pe >> 8;
#pragma unroll
        for (int e = 0; e < 8; ++e) { const unsigned long long mk = __ballot(e1 == e || e2 == e); if (lane == 0) cnt[c * 8 + e] = __popcll(mk); } }
    __syncthreads();
    if (tid < 8) { int run = 0; for (int c = 0; c < 256; ++c) { pre[c * 8 + tid] = run; run += cnt[c * 8 + tid]; } tot[tid] = run; }
    __syncthreads();
    if (tid == 0) { int b = 0; for (int e = 0; e < 8; ++e) { base[e] = b; b += (tot[e] + 255) & ~255; } base[8] = b; }
    __syncthreads();
    if (blockIdx.x == 0) { int* tl = wsp<int>(F, WS_TILES) + 256; const int ntl = base[8] >> 8;
        if (tid == 0) tl[0] = ntl;
        if (tid < MAXTILES && tid < ntl) { int e = 0; while (e < 7 && tid * 256 >= base[e + 1]) ++e; tl[1 + tid] = e; } }
    const bf16_t* H = wsp<bf16_t>(F, WS_H); unsigned char* HS = wsp<unsigned char>(F, WS_HS); int* toks = wsp<int>(F, WS_TOKS);
    for (int c = blockIdx.x; c < 256; c += F.G) {
        if (wave == 0) { const int tok = c * 64 + lane; const unsigned pe = toke[tok]; const int e1 = pe & 0xff, e2 = pe >> 8; int s1 = 0, s2 = 0;
            const unsigned long long lt = (1ull << lane) - 1ull;
#pragma unroll
            for (int e = 0; e < 8; ++e) { const unsigned long long mk = __ballot(e1 == e || e2 == e); const int slot = base[e] + pre[c * 8 + e] + __popcll(mk & lt); if (e1 == e) s1 = slot; if (e2 == e) s2 = slot; }
            toks[2 * tok] = s1; toks[2 * tok + 1] = s2; sl[2 * lane] = s1; sl[2 * lane + 1] = s2; }
        __syncthreads();
        for (int p = wave * 16; p < wave * 16 + 16; ++p) { const int tok = c * 64 + (p >> 1), slot = sl[p];
            const u32x4* src = (const u32x4*)(H + (size_t)tok * D); u32x4* dst = (u32x4*)(HS + (size_t)slot * D);
#pragma unroll
            for (int q = 0; q < 2; ++q) { const u32x4 a = src[2 * (lane + 64 * q)], b = src[2 * (lane + 64 * q) + 1]; u32x4 o;
                o.x = pk4_fp8(bf_lo(a.x) * SH8, bf_hi(a.x) * SH8, bf_lo(a.y) * SH8, bf_hi(a.y) * SH8); o.y = pk4_fp8(bf_lo(a.z) * SH8, bf_hi(a.z) * SH8, bf_lo(a.w) * SH8, bf_hi(a.w) * SH8);
                o.z = pk4_fp8(bf_lo(b.x) * SH8, bf_hi(b.x) * SH8, bf_lo(b.y) * SH8, bf_hi(b.y) * SH8); o.w = pk4_fp8(bf_lo(b.z) * SH8, bf_hi(b.z) * SH8, bf_lo(b.w) * SH8, bf_hi(b.w) * SH8);
                dst[lane + 64 * q] = o; } }
        __syncthreads();
    }
}

struct Args { const void* in[20]; float* out; unsigned char* ws; int ph_lo, ph_hi; };
constexpr int NPHASE = 18;
__global__ void __launch_bounds__(512, 2) fwd(Args args) {
    extern __shared__ __attribute__((aligned(16))) unsigned char lds[];
    Frame F;
    F.lds = (LAS unsigned char*)lds;
    F.tid = threadIdx.x; F.lane = F.tid & 63; F.wave = __builtin_amdgcn_readfirstlane(F.tid >> 6); { int w_ = F.wave; asm volatile("" : "+s"(w_)); F.wave = w_; }
    F.G = gridDim.x; { const int bx = blockIdx.x; F.vcu = (F.G % 8 == 0) ? (bx % 8) * (F.G / 8) + bx / 8 : bx; }
    F.ka = (const void* const*)&args; F.ws = args.ws; F.out = args.out;
    volatile LAS unsigned* MISC = (volatile LAS unsigned*)(F.lds + MISC_OFF);
    for (int u = F.tid; u < (LDS_BYTES - MISC_OFF) / 4; u += 512) MISC[u] = 0u;
    __syncthreads();
    unsigned* ctl = (unsigned*)(F.ws + WS_CTL);
    XcdBarrier bar; bar.bar = ctl + CW_BAR; bar.x = 0; bar.st = nullptr;
    if (!MK_PER_PHASE) bar = xcd_barrier_post(ctl + CW_BAR, MISC + 8);
    const int lo = MK_PER_PHASE ? args.ph_lo : 0, hi = MK_PER_PHASE ? args.ph_hi : NPHASE;
#define IN(k) (lo <= (k) && (k) < hi)
#define SEAM(k) do { if (IN(k) && IN((k) + 1)) xcd_barrier(bar, F.wave, (unsigned*)((unsigned char*)F.ka[opq(21)] + WS_CTL) + CW_BAR); } while (0)

    if (IN(0)) { frame_tid(F); p0_prologue(F); if (MK_DUP & 1) { __syncthreads(); p0_prologue(F); } } SEAM(0);
    for (int l = 0; l < 2; ++l) {
        const int pb = 1 + 8 * l;
        if (IN(pb + 0)) { frame_tid(F); if (MK_DUP & 2) { if (l == 0) row_phase<0>(F, 0, true); else row_phase<1>(F, 1, true); } if (l == 0) row_phase<0>(F, 0); else row_phase<1>(F, 1); } SEAM(pb + 0);
        if (IN(pb + 1)) { frame_tid(F);
            pg8::Gemm g{wsp<bf16_t>(F, WS_H), wsp<bf16_t>(F, WS_WIN) + (size_t)l * NPROJ * D, 0}; typedef pg8::StaticOrder<NPROJ / 256, S / 256> SO; SO So; So.init(0, F.G, (int)blockIdx.x, nullptr);
            pg8::EpiProj E{wsp<bf16_t>(F, WS_PROJ), wsp<float>(F, WS_ROPE), wsp<unsigned char>(F, WS_Q8), wsp<unsigned char>(F, WS_K8), wsp<unsigned char>(F, WS_Q8AB), wsp<unsigned char>(F, WS_K8AB), wsp<unsigned char>(F, WS_VT8)};
            pg8::gemm_phase<D, pg8::EpiProj, SO>(F.lds, g, So, E, F.wave); if (MK_DUP & 4) pg8::gemm_phase<D, pg8::EpiProj, SO>(F.lds, g, So, E, F.wave); } SEAM(pb + 1);
        if (IN(pb + 2)) { frame_tid(F);
#if MK_NAIVE_ATTN
            naive_attn_phase(F, l);
#else
            frame_tid(F); attn_phase(F, l, (unsigned*)(F.ws + WS_CTL), MISC);
            if (!MK_CMB) { if (!MK_PER_PHASE) xcd_barrier(bar, F.wave, (unsigned*)((unsigned char*)F.ka[opq(21)] + WS_CTL) + CW_BAR);
            frame_tid(F); attn_combine(F, l); if (MK_DUP & 128) attn_combine(F, l); }
#endif
        } SEAM(pb + 2);
        if (IN(pb + 3)) { frame_tid(F); pg8::Gemm g{wsp<bf16_t>(F, WS_O), wsp<bf16_t>(F, WS_WO) + (size_t)l * D * D, 0}; typedef pg8::StaticOrder<D / 256, S / 256> SO; SO So; So.init(0, F.G, (int)blockIdx.x, nullptr);
            pg8::EpiPlain E{wsp<bf16_t>(F, WS_Y), D, 1.f};
            pg8::gemm_phase<D, pg8::EpiPlain, SO>(F.lds, g, So, E, F.wave); if (MK_DUP & 16) pg8::gemm_phase<D, pg8::EpiPlain, SO>(F.lds, g, So, E, F.wave); } SEAM(pb + 3);
        if (IN(pb + 4)) { frame_tid(F); if (MK_DUP & 2) { if (l == 0) row_phase<2>(F, 0, true); else row_phase<3>(F, 1, true); } if (l == 0) row_phase<2>(F, 0); else row_phase<3>(F, 1); } SEAM(pb + 4);
        if (IN(pb + 5)) { frame_tid(F); if (l == 1) { sort_phase(F); if (MK_DUP & 128) sort_phase(F); } } if (l == 1) SEAM(pb + 5);
        if (IN(pb + 6)) { frame_tid(F);
            if (l == 0) { typedef pg8::StaticOrder<2 * DFF / 256, S / 256> SO; SO So; So.init(0, F.G, (int)blockIdx.x, nullptr);
                pg8::Gemm g{wsp<bf16_t>(F, WS_H), wsp<bf16_t>(F, WS_WGU), 0};
#if MK_DENSE_FP8
                pg8::EpiSwiGLU8 E{wsp<unsigned char>(F, WS_ACT), DFF};
                pg8::gemm_phase<D / 2, pg8::EpiSwiGLU8, SO, true, MK_ALIGN8>(F.lds, g, So, E, F.wave); if (MK_DUP & 32) pg8::gemm_phase<D / 2, pg8::EpiSwiGLU8, SO, true, MK_ALIGN8>(F.lds, g, So, E, F.wave);
#elif MK_DENSE_DN8
                pg8::EpiSwiGLU8b E{wsp<unsigned char>(F, WS_ACT), DFF};
                pg8::gemm_phase<D, pg8::EpiSwiGLU8b, SO, false, false>(F.lds, g, So, E, F.wave);
#else
                pg8::EpiSwiGLU E{wsp<bf16_t>(F, WS_ACT), DFF};
                pg8::gemm_phase<D, pg8::EpiSwiGLU, SO>(F.lds, g, So, E, F.wave); if (MK_DUP & 32) pg8::gemm_phase<D, pg8::EpiSwiGLU, SO>(F.lds, g, So, E, F.wave);
#endif
            }
            else { typedef pg8::StaticOrder<2 * DFF / 256, 0> SO; SO So; So.init(__builtin_amdgcn_readfirstlane((wsp<int>(F, WS_TILES) + 256)[0]), F.G, (int)blockIdx.x, wsp<int>(F, WS_TILES) + 257);
                pg8::Gemm g{wsp<bf16_t>(F, WS_HS), wsp<bf16_t>(F, WS_EGU), (size_t)2 * DFF * D};
                pg8::EpiSwiGLU8 E{wsp<unsigned char>(F, WS_ACTS), DFF};
                pg8::gemm_phase<D / 2, pg8::EpiSwiGLU8, SO, true, MK_ALIGN8>(F.lds, g, So, E, F.wave); if (MK_DUP & 32) pg8::gemm_phase<D / 2, pg8::EpiSwiGLU8, SO, true, MK_ALIGN8>(F.lds, g, So, E, F.wave); } } SEAM(pb + 6);
        if (IN(pb + 7)) { frame_tid(F);
            if (l == 0) { typedef pg8::StaticOrder<D / 256, S / 256> SO; SO So; So.init(0, F.G, (int)blockIdx.x, nullptr);
                pg8::Gemm g{wsp<bf16_t>(F, WS_ACT), wsp<bf16_t>(F, WS_WD), 0};
#if MK_DENSE_FP8 || MK_DENSE_DN8
                pg8::EpiPlain E{wsp<bf16_t>(F, WS_Y), D, 1.0f / (SA8 * SWD8)};
                pg8::gemm_phase<DFF / 2, pg8::EpiPlain, SO, true, MK_ALIGN8>(F.lds, g, So, E, F.wave); if (MK_DUP & 64) pg8::gemm_phase<DFF / 2, pg8::EpiPlain, SO, true, MK_ALIGN8>(F.lds, g, So, E, F.wave);
#else
                pg8::EpiPlain E{wsp<bf16_t>(F, WS_Y), D, 1.f};
                pg8::gemm_phase<DFF, pg8::EpiPlain, SO>(F.lds, g, So, E, F.wave); if (MK_DUP & 64) pg8::gemm_phase<DFF, pg8::EpiPlain, SO>(F.lds, g, So, E, F.wave);
#endif
            }
            else { const int ntl = __builtin_amdgcn_readfirstlane((wsp<int>(F, WS_TILES) + 256)[0]);
                pg8::Gemm g{wsp<bf16_t>(F, WS_ACTS), wsp<bf16_t>(F, WS_ED), (size_t)DFF * D};
                if (F.G == 256 && ntl >= 128 && ntl < 160) {
                    { typedef pg8::StaticOrder<D / 256, 128> SO; SO So; So.init(0, F.G, (int)blockIdx.x, wsp<int>(F, WS_TILES) + 257);
                      pg8::EpiPlain E{wsp<bf16_t>(F, WS_YP), D, 1.0f / (SA8 * SWD8)};
                      pg8::gemm_phase<DFF / 2, pg8::EpiPlain, SO, true, MK_ALIGN8>(F.lds, g, So, E, F.wave); if (MK_DUP & 64) pg8::gemm_phase<DFF / 2, pg8::EpiPlain, SO, true, MK_ALIGN8>(F.lds, g, So, E, F.wave); }
                    { pg8::SplitOrder So; So.init(ntl - 128, (int)blockIdx.x, wsp<int>(F, WS_TILES) + 257);
                      pg8::EpiPartial E{wsp<float>(F, WS_YPS), D};
                      pg8::gemm_phase<DFF / 2, pg8::EpiPartial, pg8::SplitOrder, true, MK_ALIGN8, 14>(F.lds, g, So, E, F.wave); } }
                else { typedef pg8::StaticOrder<D / 256, 0> SO; SO So; So.init(ntl, F.G, (int)blockIdx.x, wsp<int>(F, WS_TILES) + 257);
                    pg8::EpiPlain E{wsp<bf16_t>(F, WS_YP), D, 1.0f / (SA8 * SWD8)};
                    pg8::gemm_phase<DFF / 2, pg8::EpiPlain, SO, true, MK_ALIGN8>(F.lds, g, So, E, F.wave); }
                } } SEAM(pb + 7);
    }
    if (IN(17)) { frame_tid(F); if (MK_DUP & 2) row_phase<4>(F, 1, true); row_phase<4>(F, 1); }
#undef IN
#undef SEAM
}

extern "C" void kernel_launch(void* const* d_in, const int* in_sizes, int n_in, void* d_out, int out_size, void* d_ws, size_t ws_size, hipStream_t stream) {
    static int grid = 0;
    if (grid == 0) {
        if (n_in != 20 || in_sizes[0] != S * D || out_size != S * D || ws_size < WS_END) { fprintf(stderr, "kernel_launch: shape/workspace mismatch (n_in %d, in0 %d, out %d, ws %zu < %zu)\n", n_in, n_in > 0 ? in_sizes[0] : -1, out_size, ws_size, (size_t)WS_END); grid = -1; return; }
        int dev = 0, cus = 0;
        if (hipGetDevice(&dev) != hipSuccess || hipDeviceGetAttribute(&cus, hipDeviceAttributeMultiprocessorCount, dev) != hipSuccess) { grid = -1; return; }
        if (hipFuncSetAttribute((const void*)fwd, hipFuncAttributeMaxDynamicSharedMemorySize, LDS_BYTES) != hipSuccess) { fprintf(stderr, "kernel_launch: hipFuncSetAttribute failed\n"); grid = -1; return; }
        int per_cu = 0;
        if (hipOccupancyMaxActiveBlocksPerMultiprocessor(&per_cu, (const void*)fwd, 512, LDS_BYTES) != hipSuccess || per_cu < 1) fprintf(stderr, "kernel_launch: occupancy query says %d\n", per_cu);
        (void)hipGetLastError();
        grid = cus;
    }
    if (grid < 0) return;
    (void)hipMemsetAsync((char*)d_ws + WS_CTL, 0, CTL_ZERO_BYTES, stream);
    Args a{};
    for (int i = 0; i < 20; ++i) a.in[i] = d_in[i];
    a.out = (float*)d_out; a.ws = (unsigned char*)d_ws;
#if MK_PER_PHASE
    for (int p = 0; p < NPHASE; ++p) { if (p == 6) continue; a.ph_lo = p; a.ph_hi = p + 1; hipLaunchKernelGGL(fwd, dim3(grid), dim3(512), LDS_BYTES, stream, a); }
#else
    a.ph_lo = 0; a.ph_hi = NPHASE;
    hipLaunchKernelGGL(fwd, dim3(grid), dim3(512), LDS_BYTES, stream, a);
#endif
    const hipError_t le = hipPeekAtLastError();
    if (le != hipSuccess) fprintf(stderr, "kernel_launch: launch failed: %s\n", hipGetErrorName(le));
}
```

```cpp
#include <hip/hip_runtime.h>
#include <cstdio>
#include <cstdint>

#ifndef MK_PER_PHASE
#define MK_PER_PHASE 0
#endif

#ifndef MK_DUP
#define MK_DUP 0
#endif
#ifndef MK_DENSE_FP8
#define MK_DENSE_FP8 0
#endif
#ifndef MK_DENSE_DN8
#define MK_DENSE_DN8 1
#endif
#ifndef MK_WT
#define MK_WT 0
#endif
#ifndef MK_ALIGN8
#define MK_ALIGN8 true
#endif
#ifndef MK_NAIVE_ATTN
#define MK_NAIVE_ATTN 0
#endif
#ifndef MK_PV8
#define MK_PV8 1
#endif
#ifndef MK_QK8
#define MK_QK8 1
#endif
#ifndef MK_LS8
#define MK_LS8 1
#endif
#ifndef MK_STEPF
#define MK_STEPF 1
#endif
#ifndef MK_CMB
#define MK_CMB 1
#endif
#ifndef MK_QK8AB
#define MK_QK8AB 1
#endif
#ifndef MK_XCONV
#define MK_XCONV 1
#endif
#ifndef MK_KHALF
#define MK_KHALF 1
#endif
#define LAS __attribute__((address_space(3)))
#define GAS __attribute__((address_space(1)))
typedef unsigned short bf16_t;
typedef short bf16x8 __attribute__((ext_vector_type(8)));
typedef float f32x4 __attribute__((ext_vector_type(4)));
typedef float f32x2 __attribute__((ext_vector_type(2)));
typedef unsigned u32x4 __attribute__((ext_vector_type(4)));
typedef unsigned u32x2 __attribute__((ext_vector_type(2)));
typedef int i32x8 __attribute__((ext_vector_type(8)));
typedef int i32x4 __attribute__((ext_vector_type(4)));

constexpr int S = 16384, D = 2048, DFF = 7168, NE = 8, NPROJ = 6144, DIN = 6150;
constexpr int NHA = 6, NHB = 6, NHC = 4, HD = 128;
constexpr int QA = 0, KA = 768, VA = 1536, QB_ = 2304, KB_ = 3072, VB_ = 3840, QC = 4608, KC = 5120, VC = 5632;
constexpr float EPS = 1e-6f;
constexpr float LOG2E = 1.4426950408889634f;
constexpr float SCALE_A = 0.08838834764831845f * LOG2E;
constexpr float SCALE_C = 0.125f * LOG2E;
constexpr int MAXTILES = 136, MAXSLOTS = MAXTILES * 256;
constexpr int NMODP = 16;
constexpr float SH8 = 4.f, SW8 = 32.f, SA8 = 8.f, SWD8 = 64.f;

constexpr size_t MiB = 1u << 20;
constexpr size_t WS_CTL = 0, CTL_ZERO_BYTES = 64 * 1024;
constexpr size_t WS_MODP = 1 * MiB;
constexpr size_t WS_ROPE = 3 * MiB;
constexpr size_t WS_LOGF = 4 * MiB;
constexpr size_t WS_FREL = 5 * MiB;
constexpr size_t WS_FBASE = 5 * MiB + 512 * 1024;
constexpr size_t WS_QN = 5 * MiB + 640 * 1024;
constexpr size_t WS_KN = 5 * MiB + 704 * 1024;
constexpr size_t WS_TOKE = 6 * MiB;
constexpr size_t WS_TOKG = 6 * MiB + 256 * 1024;
constexpr size_t WS_TOKS = 6 * MiB + 512 * 1024;
constexpr size_t WS_TILES = 6 * MiB + 768 * 1024;
constexpr size_t WS_FD = 7 * MiB;
constexpr size_t WS_WIN = 16 * MiB;
constexpr size_t WS_WO = 64 * MiB;
constexpr size_t WS_WGU = 80 * MiB;
constexpr size_t WS_WD = 136 * MiB;
constexpr size_t WS_EGU = 164 * MiB;
constexpr size_t WS_XB = 400 * MiB;
constexpr size_t WS_YPS = 464 * MiB;
constexpr size_t WS_ED = 612 * MiB;
constexpr size_t WS_H = 836 * MiB;
constexpr size_t WS_Y = 900 * MiB;
constexpr size_t WS_CST = WS_Y;
constexpr size_t WS_VT8 = 964 * MiB;
constexpr size_t WS_Q8 = 972 * MiB, WS_K8 = 980 * MiB;
constexpr size_t WS_BIG = 996 * MiB;
constexpr size_t WS_PROJ = WS_BIG;
constexpr size_t WS_O = WS_BIG + 192 * MiB;
constexpr size_t WS_ACT = WS_BIG;
constexpr size_t WS_HS = WS_BIG;
constexpr size_t WS_ACTS = WS_BIG + 136 * MiB;
constexpr size_t WS_YP = WS_BIG + 612 * MiB;
constexpr size_t WS_Q8AB = WS_BIG + 748 * MiB, WS_K8AB = WS_BIG + 772 * MiB;
constexpr size_t WS_END = WS_BIG + 796 * MiB;
constexpr int CW_TMO = 0, CW_CODE = 1;
constexpr int CW_BAR = 4096;
constexpr int CW_CMB = 8192;

constexpr int RING_BYTES = 135168;
constexpr int MISC_OFF = RING_BYTES;
constexpr int LDS_BYTES = 147456;

__device__ __forceinline__ unsigned cvt_pk_bf16(float lo, float hi) { unsigned r; asm("v_cvt_pk_bf16_f32 %0, %1, %2" : "=v"(r) : "v"(lo), "v"(hi)); return r; }
__device__ __forceinline__ unsigned pk4_fp8(float a, float b, float c, float d) {
    a = __builtin_amdgcn_fmed3f(a, -448.f, 448.f); b = __builtin_amdgcn_fmed3f(b, -448.f, 448.f); c = __builtin_amdgcn_fmed3f(c, -448.f, 448.f); d = __builtin_amdgcn_fmed3f(d, -448.f, 448.f);
    int w = 0; w = __builtin_amdgcn_cvt_pk_fp8_f32(a, b, w, false); w = __builtin_amdgcn_cvt_pk_fp8_f32(c, d, w, true); return (unsigned)w; }
__device__ __forceinline__ void st16(void* p, u32x4 v) {
#if MK_WT
    asm volatile("global_store_dwordx4 %0, %1, off sc0 sc1" :: "v"(p), "v"(v) : "memory");
#else
    *(u32x4*)p = v;
#endif
}
__device__ __forceinline__ void st8(void* p, u32x2 v) {
#if MK_WT
    asm volatile("global_store_dwordx2 %0, %1, off sc0 sc1" :: "v"(p), "v"(v) : "memory");
#else
    *(u32x2*)p = v;
#endif
}
__device__ __forceinline__ float bf_lo(unsigned w) { return __uint_as_float(w << 16); }
__device__ __forceinline__ float bf_hi(unsigned w) { return __uint_as_float(w & 0xffff0000u); }
template <int M> __device__ __forceinline__ float sxor(float v) { return __int_as_float(__builtin_amdgcn_ds_swizzle(__float_as_int(v), (M << 10) | 0x1f)); }
__device__ __forceinline__ float half_sum(float v) { auto rr = __builtin_amdgcn_permlane32_swap(__float_as_uint(v), __float_as_uint(v), false, false); return __uint_as_float(rr[0]) + __uint_as_float(rr[1]); }
__device__ __forceinline__ float half_max(float v) { auto rr = __builtin_amdgcn_permlane32_swap(__float_as_uint(v), __float_as_uint(v), false, false); return fmaxf(__uint_as_float(rr[0]), __uint_as_float(rr[1])); }
__device__ __forceinline__ float wave_sum(float v) { v += sxor<1>(v); v += sxor<2>(v); v += sxor<4>(v); v += sxor<8>(v); v += sxor<16>(v); return half_sum(v); }
__device__ __forceinline__ float wave_max(float v) { v = fmaxf(v, sxor<1>(v)); v = fmaxf(v, sxor<2>(v)); v = fmaxf(v, sxor<4>(v)); v = fmaxf(v, sxor<8>(v)); v = fmaxf(v, sxor<16>(v)); return half_max(v); }
__device__ __forceinline__ int opq(int i) { asm volatile("" : "+s"(i)); return i; }
__device__ __forceinline__ int lane_now() { int t; asm volatile("v_mbcnt_lo_u32_b32 %0, -1, 0\n\tv_mbcnt_hi_u32_b32 %0, -1, %0" : "=v"(t)); return t; }
__device__ __forceinline__ int launder_tid(int wave) { return wave * 64 + lane_now(); }
#define LDS_WAIT() asm volatile("s_waitcnt lgkmcnt(0)" ::: "memory")
#define VM_WAIT() asm volatile("s_waitcnt vmcnt(0)" ::: "memory")

namespace pg8 {
constexpr int BM = 256, BK = 64, HALF = 128, HTB = HALF * BK * 2, STAGE_BYTES = 8 * HTB, NXCD = 8, WGM = 4;
__host__ __device__ __forceinline__ int lds_byte(int r, int c) { const int st = (r >> 4) * 2 + (c >> 5), rr = r & 15, cc = c & 31, ob = rr * 64 + cc * 2; return st * 1024 + (ob ^ (((ob >> 9) & 1) << 5)); }
__host__ __device__ __forceinline__ void stage_rc(int b, int& R, int& C) { const int st = b / 1024, sb = b % 1024, swz = sb ^ (((sb >> 9) & 1) << 5); R = (st >> 1) * 16 + swz / 64; C = (st & 1) * 32 + (swz % 64) / 2; }
__host__ __device__ __forceinline__ void stage_rc8(int b, int& R, int& C) { const int p = b >> 4, g = p >> 7, h = (p >> 6) & 1, fq = (p >> 4) & 3, rr = p & 15; R = 16 * g + rr; C = 8 * (2 * fq + h); }
__host__ __device__ __forceinline__ int perm32(int rho) { const int n = rho >> 4, i = rho & 15; return 8 * (i >> 2) + 4 * n + (i & 3); }

struct Unit { int pm, pn, e, ks; };
struct Gemm { const bf16_t* A; const bf16_t* Bt; size_t bstride; };

template <int NN, int NMC>
struct StaticOrder {
    int nMr, G, c; const int* texp;
    __device__ void init(int nM_, int G_, int c_, const int* texp_) { nMr = nM_; G = G_; c = c_; texp = texp_; }
    __device__ bool next(int i, Unit& u) const {
        const int nM = NMC ? NMC : nMr, nN = NN, nwg = nM * nN;
        const long L = (long)i * G + c; if (L >= nwg) return false;
        int wgid = (int)L; { const int q = nwg / NXCD, r = nwg % NXCD, xcd = wgid % NXCD, off = wgid / NXCD; wgid = (xcd < r ? xcd * (q + 1) : r * (q + 1) + (xcd - r) * q) + off; }
        const int nig = WGM * nN, gid = wgid / nig, fm = gid * WGM, gsz = (nM - fm) < WGM ? (nM - fm) : WGM;
        u.pm = fm + ((wgid % nig) % gsz); u.pn = (wgid % nig) / gsz; u.e = texp ? __builtin_amdgcn_readfirstlane(texp[u.pm]) : 0; u.ks = 0; return true;
    }
};
struct SplitOrder {
    int rt, c; const int* texp;
    __device__ void init(int rt_, int c_, const int* texp_) { rt = rt_; c = c_; texp = texp_; }
    __device__ bool next(int i, Unit& u) const { if (i > 0 || c >= 32 * rt) return false; u.pm = 128 + (c >> 5); u.pn = (c >> 2) & 7; u.ks = c & 3; u.e = __builtin_amdgcn_readfirstlane(texp[u.pm]); return true; }
};

struct EpiPlain {
    static constexpr bool PERM = true;
    bf16_t* O; int ldc; float sc;
    __device__ __forceinline__ void operator()(const f32x4 (&acc)[2][2][4][2], const Unit& u, int wr, int wc, int fr, int fq) const {
        const int row0 = u.pm * BM + wr * 64 + fr, col0 = u.pn * BM + wc * 32 + 8 * fq;
#pragma unroll
        for (int ai = 0; ai < 2; ++ai)
#pragma unroll
            for (int m = 0; m < 4; ++m) { bf16_t* rowp = O + (size_t)(row0 + ai * HALF + m * 16) * ldc + col0;
#pragma unroll
                for (int bj = 0; bj < 2; ++bj) { const f32x4 v0 = acc[ai][bj][m][0] * sc, v1 = acc[ai][bj][m][1] * sc;
                    u32x4 w; w.x = cvt_pk_bf16(v0[0], v0[1]); w.y = cvt_pk_bf16(v0[2], v0[3]); w.z = cvt_pk_bf16(v1[0], v1[1]); w.w = cvt_pk_bf16(v1[2], v1[3]);
                    st16(rowp + bj * HALF, w); } }
    }
};
struct EpiPartial {
    static constexpr bool PERM = true;
    float* O; int ldc;
    __device__ __forceinline__ void operator()(const f32x4 (&acc)[2][2][4][2], const Unit& u, int wr, int wc, int fr, int fq) const {
        const int row0 = (u.ks * 8 + (u.pm - 128)) * BM + wr * 64 + fr, col0 = u.pn * BM + wc * 32 + 8 * fq;
#pragma unroll
        for (int ai = 0; ai < 2; ++ai)
#pragma unroll
            for (int m = 0; m < 4; ++m) { float* rowp = O + (size_t)(row0 + ai * HALF + m * 16) * ldc + col0;
#pragma unroll
                for (int bj = 0; bj < 2; ++bj) { *(f32x4*)(rowp + bj * HALF) = acc[ai][bj][m][0]; *(f32x4*)(rowp + bj * HALF + 4) = acc[ai][bj][m][1]; } }
    }
};
struct EpiSwiGLU8 {
    static constexpr bool PERM = true;
    unsigned char* O; int ldc;
    __device__ __forceinline__ void operator()(const f32x4 (&acc)[2][2][4][2], const Unit& u, int wr, int wc, int fr, int fq) const {
        const int row0 = u.pm * BM + wr * 64 + fr, col0 = u.pn * HALF + wc * 32 + 8 * fq;
        constexpr float IS = 1.0f / (SH8 * SW8);
#pragma unroll
        for (int ai = 0; ai < 2; ++ai)
#pragma unroll
            for (int m = 0; m < 4; ++m) { unsigned char* rowp = O + (size_t)(row0 + ai * HALF + m * 16) * ldc + col0;
                float r[8];
#pragma unroll
                for (int n = 0; n < 2; ++n)
#pragma unroll
                    for (int q = 0; q < 4; ++q) { const float g = acc[ai][0][m][n][q] * IS, up = acc[ai][1][m][n][q] * (IS * SA8);
                        const float sg = g * __builtin_amdgcn_rcpf(1.0f + __builtin_amdgcn_exp2f(-g * LOG2E)); r[n * 4 + q] = sg * up; }
                u32x2 w; w.x = pk4_fp8(r[0], r[1], r[2], r[3]); w.y = pk4_fp8(r[4], r[5], r[6], r[7]);
                st8(rowp, w); }
    }
};
struct EpiSwiGLU8b {
    static constexpr bool PERM = true;
    unsigned char* O; int ldc;
    __device__ __forceinline__ void operator()(const f32x4 (&acc)[2][2][4][2], const Unit& u, int wr, int wc, int fr, int fq) const {
        const int row0 = u.pm * BM + wr * 64 + fr, col0 = u.pn * HALF + wc * 32 + 8 * fq;
        constexpr float IS = 1.0f;
#pragma unroll
        for (int ai = 0; ai < 2; ++ai)
#pragma unroll
            for (int m = 0; m < 4; ++m) { unsigned char* rowp = O + (size_t)(row0 + ai * HALF + m * 16) * ldc + col0;
                float r[8];
#pragma unroll
                for (int n = 0; n < 2; ++n)
#pragma unroll
                    for (int q = 0; q < 4; ++q) { const float g = acc[ai][0][m][n][q] * IS, up = acc[ai][1][m][n][q] * (IS * SA8);
                        const float sg = g * __builtin_amdgcn_rcpf(1.0f + __builtin_amdgcn_exp2f(-g * LOG2E)); r[n * 4 + q] = sg * up; }
                u32x2 w; w.x = pk4_fp8(r[0], r[1], r[2], r[3]); w.y = pk4_fp8(r[4], r[5], r[6], r[7]);
                st8(rowp, w); }
    }
};
struct EpiSwiGLU {
    static constexpr bool PERM = true;
    bf16_t* O; int ldc;
    __device__ __forceinline__ void operator()(const f32x4 (&acc)[2][2][4][2], const Unit& u, int wr, int wc, int fr, int fq) const {
        const int row0 = u.pm * BM + wr * 64 + fr, col0 = u.pn * HALF + wc * 32 + 8 * fq;
#pragma unroll
        for (int ai = 0; ai < 2; ++ai)
#pragma unroll
            for (int m = 0; m < 4; ++m) { bf16_t* rowp = O + (size_t)(row0 + ai * HALF + m * 16) * ldc + col0;
                float r[8];
#pragma unroll
                for (int n = 0; n < 2; ++n)
#pragma unroll
                    for (int q = 0; q < 4; ++q) { const float g = acc[ai][0][m][n][q], up = acc[ai][1][m][n][q];
                        const float sg = g * __builtin_amdgcn_rcpf(1.0f + __builtin_amdgcn_exp2f(-g * LOG2E)); r[n * 4 + q] = sg * up; }
                u32x4 w; w.x = cvt_pk_bf16(r[0], r[1]); w.y = cvt_pk_bf16(r[2], r[3]); w.z = cvt_pk_bf16(r[4], r[5]); w.w = cvt_pk_bf16(r[6], r[7]);
                st16(rowp, w); }
    }
};
constexpr float fa_SV8 = 16.f;
constexpr float fa_SQ8 = 4.f, fa_SK8 = 0.25f;
struct EpiProj {
    static constexpr bool PERM = true;
    bf16_t* O; const float* rope;
    unsigned char* q8; unsigned char* k8;
    unsigned char* q8ab; unsigned char* k8ab;
    unsigned char* vt8;
    __device__ __forceinline__ void operator()(const f32x4 (&acc)[2][2][4][2], const Unit& u, int wr, int wc, int fr, int fq) const {
        const int row0 = u.pm * BM + wr * 64 + fr, col0 = u.pn * BM + wc * 32 + 8 * fq, pn = u.pn;
        float sc = 1.f; if (pn < 3 || (pn >= 9 && pn < 12)) sc = SCALE_A; else if (pn == 18 || pn == 19) sc = SCALE_C;
        const bool rp = (pn >= 18 && pn < 22) && ((wc & 1) == 0);
#pragma unroll
        for (int ai = 0; ai < 2; ++ai)
#pragma unroll
            for (int m = 0; m < 4; ++m) { const int row = row0 + ai * HALF + m * 16; bf16_t* rowp = O + (size_t)row * NPROJ + col0;
                f32x4 cs0 = {1.f, 1.f, 1.f, 1.f}, cs1 = cs0, sn0 = {0.f, 0.f, 0.f, 0.f}, sn1 = sn0;
                if (rp && fq < 2) { const f32x4* rr = (const f32x4*)(rope + (size_t)row * 16); cs0 = rr[0]; cs1 = rr[1]; sn0 = rr[2]; sn1 = rr[3]; if (fq == 0) { sn0 = -sn0; sn1 = -sn1; } }
#pragma unroll
                for (int bj = 0; bj < 2; ++bj) { f32x4 v0 = acc[ai][bj][m][0], v1 = acc[ai][bj][m][1];
                    if (rp) { f32x4 w0, w1;
#pragma unroll
                        for (int q = 0; q < 4; ++q) { w0[q] = sxor<16>(v0[q]); w1[q] = sxor<16>(v1[q]); }
                        v0 = v0 * cs0 + w0 * sn0; v1 = v1 * cs1 + w1 * sn1; }
                    v0 = v0 * sc; v1 = v1 * sc;
                    if (MK_QK8AB && (pn < 6 || (pn >= 9 && pn < 15))) {
                        const bool isq = pn < 3 || (pn >= 9 && pn < 12); const float s8 = isq ? fa_SQ8 : fa_SK8;
                        const int head = (pn < 6 ? (pn % 3) * 2 : 6 + ((pn - 9) % 3) * 2) + bj;
                        unsigned char* qp = (isq ? q8ab : k8ab) + ((size_t)head * S + row) * 128 + wc * 32 + 8 * fq;
                        u32x2 w8; w8.x = pk4_fp8(v0[0] * s8, v0[1] * s8, v0[2] * s8, v0[3] * s8); w8.y = pk4_fp8(v1[0] * s8, v1[1] * s8, v1[2] * s8, v1[3] * s8);
                        st8(qp, w8); }
                    if (MK_QK8AB && pn >= 9 && pn < 15) { }
                    else if (MK_QK8 && pn >= 18 && pn < 22) {
                        const float s8 = pn < 20 ? fa_SQ8 : fa_SK8; const int head = ((pn - 18) & 1) * 2 + bj;
                        unsigned char* qp = (pn < 20 ? q8 : k8) + ((size_t)(head * 2 + (wc >> 1)) * S + row) * 64 + (wc & 1) * 32 + 8 * fq;
                        u32x2 w; w.x = pk4_fp8(v0[0] * s8, v0[1] * s8, v0[2] * s8, v0[3] * s8); w.y = pk4_fp8(v1[0] * s8, v1[1] * s8, v1[2] * s8, v1[3] * s8);
                        st8(qp, w);
                    } else if (MK_PV8 && pn >= 22) {
                        const int head = (pn - 22) * 2 + bj, tile = 4 * u.pm + 2 * ai + wr, k = 16 * m + fr, kk = k & 31, kpos = 32 * ((kk >> 2) & 1) + 16 * (k >> 5) + (kk & 3) + 4 * (kk >> 3);
                        unsigned char* vp = vt8 + ((size_t)(head * 256 + tile) * 128 + wc * 32 + 8 * fq) * 64 + kpos;
                        const unsigned wa = pk4_fp8(v0[0] * fa_SV8, v0[1] * fa_SV8, v0[2] * fa_SV8, v0[3] * fa_SV8), wb = pk4_fp8(v1[0] * fa_SV8, v1[1] * fa_SV8, v1[2] * fa_SV8, v1[3] * fa_SV8);
#pragma unroll
                        for (int j = 0; j < 4; ++j) { vp[j * 64] = (unsigned char)(wa >> (8 * j)); vp[(4 + j) * 64] = (unsigned char)(wb >> (8 * j)); }
                    } else {
                    u32x4 w; w.x = cvt_pk_bf16(v0[0], v0[1]); w.y = cvt_pk_bf16(v0[2], v0[3]); w.z = cvt_pk_bf16(v1[0], v1[1]); w.w = cvt_pk_bf16(v1[2], v1[3]);
                    st16(rowp + bj * HALF, w); } } }
    }
};

__device__ __forceinline__ void glds16s(unsigned voff, const void* sbase, unsigned ldsaddr) { unsigned keep;
    asm volatile("s_mov_b32 %0, m0\n\ts_mov_b32 m0, %3\n\ts_nop 0\n\tglobal_load_lds_dwordx4 %1, %2\n\ts_mov_b32 m0, %0" : "=&s"(keep) : "v"(voff), "s"(sbase), "s"(ldsaddr) : "memory"); }
template <int K, class Epi, class Sched, bool FP8 = false, bool ALIGN_EPI = true, int NT_ = 0>
__device__ __forceinline__ void gemm_phase(LAS unsigned char* lds, const Gemm g, const Sched& S, const Epi& E, int wave_) {
    const int tid = launder_tid(wave_), wid = wave_, lane = tid & 63, wr = wid >> 2, wc = wid & 3, fr = lane & 15, fq = lane >> 4;
    constexpr int nt = NT_ ? NT_ : K / BK; constexpr size_t KSB = (size_t)nt * BK * 2;
    unsigned voffA, voffB;
    { int R, C; if constexpr (FP8) stage_rc8(tid * 16, R, C); else stage_rc(tid * 16, R, C); const int Rb = Epi::PERM ? ((R & ~31) + perm32(R & 31)) : R;
        voffA = (unsigned)(R * K + C) * 2u; voffB = (unsigned)(Rb * K + C) * 2u; }
    const size_t qstep = (size_t)64 * K * 2;
    const size_t kstep = (size_t)(BK * 2);
    const size_t hstep = (size_t)HALF * K * 2;
    const size_t tstep = 2 * hstep;
    const unsigned ldsb = (unsigned)(uintptr_t)lds + (unsigned)wid * 1024u;
    const int aoff = FP8 ? wr * 8192 + (fq * 16 + fr) * 16 : lds_byte(wr * 64 + fr, fq * 8), boff = FP8 ? wc * 4096 + (fq * 16 + fr) * 16 : lds_byte(wc * 32 + fr, fq * 8);
#define PG8_SA(b, h) (((b) * 2 + (h)) * HTB)
#define PG8_SB(b, h) ((4 + (b) * 2 + (h)) * HTB)
#define PG8_STAGE(bufoff, gbase, voff) do { _Pragma("unroll") for (int _i = 0; _i < 2; ++_i) glds16s((voff), (const void*)((const char*)(gbase) + _i * qstep), ldsb + (unsigned)((bufoff) + _i * 8192)); } while (0)
#define PG8_LDA(dst, b, h) do { if constexpr (FP8) { _Pragma("unroll") for (int m = 0; m < 4; ++m) { dst##8[m].lo = *(const LAS i32x4*)(lds + PG8_SA(b, h) + aoff + m * 2048); dst##8[m].hi = *(const LAS i32x4*)(lds + PG8_SA(b, h) + aoff + m * 2048 + 1024); } } \
        else { _Pragma("unroll") for (int m = 0; m < 4; ++m) _Pragma("unroll") for (int k = 0; k < 2; ++k) dst[m][k] = *(const LAS bf16x8*)(lds + PG8_SA(b, h) + aoff + m * 2048 + k * 1024); } } while (0)
#define PG8_LDB(dst, b, h) do { if constexpr (FP8) { _Pragma("unroll") for (int n = 0; n < 2; ++n) { dst##8[n].lo = *(const LAS i32x4*)(lds + PG8_SB(b, h) + boff + n * 2048); dst##8[n].hi = *(const LAS i32x4*)(lds + PG8_SB(b, h) + boff + n * 2048 + 1024); } } \
        else { _Pragma("unroll") for (int n = 0; n < 2; ++n) _Pragma("unroll") for (int k = 0; k < 2; ++k) dst[n][k] = *(const LAS bf16x8*)(lds + PG8_SB(b, h) + boff + n * 2048 + k * 1024); } } while (0)
#define PG8_MMA(ai, bj, At, Bt) do { __builtin_amdgcn_s_setprio(1); \
        if constexpr (FP8) { _Pragma("unroll") for (int m = 0; m < 4; ++m) _Pragma("unroll") for (int n = 0; n < 2; ++n) \
            acc[ai][bj][m][n] = __builtin_amdgcn_mfma_scale_f32_16x16x128_f8f6f4(Bt##8[n], At##8[m], acc[ai][bj][m][n], 0, 0, 0, 0, 0, 0); } \
        else { _Pragma("unroll") for (int m = 0; m < 4; ++m) _Pragma("unroll") for (int n = 0; n < 2; ++n) _Pragma("unroll") for (int k = 0; k < 2; ++k) \
            acc[ai][bj][m][n] = __builtin_amdgcn_mfma_f32_16x16x32_bf16(Bt[n][k], At[m][k], acc[ai][bj][m][n], 0, 0, 0); } \
        __builtin_amdgcn_s_setprio(0); } while (0)
#define PG8_WAIT_V(n) asm volatile("s_waitcnt vmcnt(" #n ")" ::: "memory")
#define PG8_WAIT_L(n) asm volatile("s_waitcnt lgkmcnt(" #n ")" ::: "memory")
#define PG8_BAR __builtin_amdgcn_s_barrier()
#define PG8_SCHED __builtin_amdgcn_sched_barrier(0)
    Unit cur, nxt; int ui = 0;
    if (!S.next(0, cur)) return;
    f32x4 acc[2][2][4][2];
#pragma unroll
    for (int a = 0; a < 2; ++a)
#pragma unroll
        for (int b = 0; b < 2; ++b)
#pragma unroll
            for (int m = 0; m < 4; ++m)
#pragma unroll
                for (int n = 0; n < 2; ++n) acc[a][b][m][n] = (f32x4){0.f, 0.f, 0.f, 0.f};
    bf16x8 At[4][2], B0[2][2], B1[2][2]; i32x8 At8[4], B08[2], B18[2];
    const char* cA = (const char*)g.A + (size_t)cur.pm * tstep + (NT_ ? (size_t)cur.ks * KSB : 0); const char* cB = (const char*)g.Bt + (size_t)cur.e * g.bstride + (size_t)cur.pn * tstep + (NT_ ? (size_t)cur.ks * KSB : 0);
    PG8_STAGE(PG8_SB(0, 0), cB, voffB); PG8_STAGE(PG8_SB(0, 1), cB + hstep, voffB); PG8_STAGE(PG8_SA(0, 0), cA, voffA); PG8_STAGE(PG8_SA(0, 1), cA + hstep, voffA);
    if (wr == 1) PG8_BAR;
    PG8_WAIT_V(2); PG8_BAR;
    PG8_STAGE(PG8_SB(1, 0), cB + kstep, voffB); PG8_STAGE(PG8_SA(1, 0), cA + kstep, voffA); PG8_STAGE(PG8_SB(1, 1), cB + hstep + kstep, voffB);
    PG8_WAIT_V(6); PG8_BAR;
    for (;;) {
        const bool has_next = S.next(ui + 1, nxt);
        const char* nA = has_next ? (const char*)g.A + (size_t)nxt.pm * tstep + (NT_ ? (size_t)nxt.ks * KSB : 0) : cA; const char* nB = has_next ? (const char*)g.Bt + (size_t)nxt.e * g.bstride + (size_t)nxt.pn * tstep + (NT_ ? (size_t)nxt.ks * KSB : 0) : cB;
        for (int t = 0; t < nt; t += 2) {
            const bool last = (t == nt - 2);
            const char* a1 = cA + (size_t)(t + 1) * kstep;
            const char* a2 = last ? nA : cA + (size_t)(t + 2) * kstep; const char* b2 = last ? nB : cB + (size_t)(t + 2) * kstep;
            const char* a3 = a2 + kstep; const char* b3 = b2 + kstep;
            PG8_LDB(B0, 0, 0); PG8_LDB(B1, 0, 1); PG8_SCHED; PG8_LDA(At, 0, 0); PG8_STAGE(PG8_SA(1, 1), a1 + hstep, voffA);
            PG8_WAIT_V(8); PG8_WAIT_L(0); PG8_BAR; PG8_MMA(0, 0, At, B0); PG8_MMA(0, 1, At, B1); PG8_BAR; PG8_SCHED;
            PG8_LDA(At, 0, 1); PG8_STAGE(PG8_SB(0, 0), b2, voffB); PG8_STAGE(PG8_SB(0, 1), b2 + hstep, voffB); PG8_STAGE(PG8_SA(0, 0), a2, voffA);
            PG8_WAIT_V(8); PG8_WAIT_L(0); PG8_BAR; PG8_MMA(1, 0, At, B0); PG8_MMA(1, 1, At, B1); PG8_BAR; PG8_SCHED;
            PG8_LDB(B0, 1, 0); PG8_LDB(B1, 1, 1); PG8_SCHED; PG8_LDA(At, 1, 0); PG8_STAGE(PG8_SA(0, 1), a2 + hstep, voffA);
            PG8_WAIT_V(8); PG8_WAIT_L(0); PG8_BAR; PG8_MMA(0, 0, At, B0); PG8_MMA(0, 1, At, B1); PG8_BAR; PG8_SCHED;
            PG8_LDA(At, 1, 1); PG8_STAGE(PG8_SB(1, 0), b3, voffB); PG8_STAGE(PG8_SB(1, 1), b3 + hstep, voffB); PG8_STAGE(PG8_SA(1, 0), a3, voffA);
            PG8_WAIT_V(8); PG8_WAIT_L(0); PG8_BAR; PG8_MMA(1, 0, At, B0); PG8_MMA(1, 1, At, B1); PG8_BAR; PG8_SCHED;
        }
        if constexpr (ALIGN_EPI) { if (wr == 0) PG8_BAR; }
        if constexpr (FP8) { const int ln_ = lane_now(); E(acc, cur, wr, wc, ln_ & 15, ln_ >> 4); }
        else E(acc, cur, wr, wc, fr, fq);
        if (!has_next) break;
#pragma unroll
        for (int a = 0; a < 2; ++a)
#pragma unroll
            for (int b = 0; b < 2; ++b)
#pragma unroll
                for (int m = 0; m < 4; ++m)
#pragma unroll
                    for (int n = 0; n < 2; ++n) acc[a][b][m][n] = (f32x4){0.f, 0.f, 0.f, 0.f};
        cur = nxt; cA = nA; cB = nB; ++ui;
        if constexpr (ALIGN_EPI) { if (wr == 1) PG8_BAR; }
    }
    PG8_WAIT_V(0);
    if constexpr (!ALIGN_EPI) { if (wr == 0) PG8_BAR; }
    PG8_BAR;
#undef PG8_SA
#undef PG8_SB
#undef PG8_STAGE
#undef PG8_LDA
#undef PG8_LDB
#undef PG8_MMA
#undef PG8_WAIT_V
#undef PG8_WAIT_L
#undef PG8_BAR
#undef PG8_SCHED
}
}

typedef GAS unsigned gu32;
#define RLX_AGENT __ATOMIC_RELAXED, __HIP_MEMORY_SCOPE_AGENT
#define XB_TMO      128
#define XB_XCNT(j)  (256  + 64 * (j))
#define XB_XSUB(j)  (1280 + 64 * (j))
#define XB_XGEN(j)  (2304 + 64 * (j))
#define XB_TOP      3328
#define XB_TOPGEN   3392
#define XCD_BAR_WORDS 3456
#define XB_SPIN_CAP (1u << 22)
__device__ __forceinline__ unsigned xb_ld(unsigned* p)              { return __hip_atomic_load(p, __ATOMIC_RELAXED, __HIP_MEMORY_SCOPE_AGENT); }
__device__ __forceinline__ unsigned xb_add(unsigned* p, unsigned v) { return __hip_atomic_fetch_add(p, v, __ATOMIC_RELAXED, __HIP_MEMORY_SCOPE_AGENT); }
__device__ __forceinline__ unsigned xb_xcc_id() { return (unsigned)__builtin_amdgcn_s_getreg((3 << 11) | 20) & 0xFu; }
#define XB_SPIN(cond, bar) do { unsigned _sp = 0; while (cond) { __builtin_amdgcn_s_sleep(1); \
    if ((++_sp & 255u) == 0u) { if (xb_ld(&(bar)[XB_TMO])) break; if (_sp > XB_SPIN_CAP) { atomicAdd(&(bar)[XB_TMO], 1u); break; } } } } while (0)
struct XcdBarrier { unsigned* bar; unsigned x; volatile LAS unsigned* st; };
__device__ __forceinline__ XcdBarrier xcd_barrier_post(unsigned* bar, volatile LAS unsigned* st) {
    XcdBarrier b; b.bar = bar; b.x = xb_xcc_id(); b.st = st;
    if (threadIdx.x == 0) (void)xb_add(&bar[XB_XCNT(b.x)], 1u);
    b.x = 0;
    return b;
}
__device__ __forceinline__ void xcd_barrier_complete(unsigned* bar, unsigned x, unsigned& nloc, unsigned& nx) {
    const unsigned G = gridDim.x * gridDim.y * gridDim.z;
    unsigned sum, cnt, mine, sp = 0u;
    for (;;) {
        sum = 0u; cnt = 0u; mine = 0u;
#pragma unroll
        for (unsigned j = 0; j < 16; ++j) { const unsigned c = xb_ld(&bar[XB_XCNT(j)]); sum += c; cnt += (c > 0u) ? 1u : 0u; mine = (j == x) ? c : mine; }
        if (sum == G) break;
        __builtin_amdgcn_s_sleep(1);
        if ((++sp & 255u) == 0u) { if (xb_ld(&bar[XB_TMO])) break; if (sp > XB_SPIN_CAP) { atomicAdd(&bar[XB_TMO], 1u); break; } }
    }
    nloc = mine > 0u ? mine : 1u; nx = cnt > 0u ? cnt : 1u;
}
__device__ __forceinline__ void xcd_barrier(const XcdBarrier& b, int wave_, unsigned* barp) {
    asm volatile("s_waitcnt vmcnt(0)" ::: "memory");
    __syncthreads();
    if (wave_ == 0 && lane_now() == 0) {
        unsigned* bar = barp;
        __builtin_amdgcn_s_waitcnt(0);
        const unsigned bx_ = xb_xcc_id();
        unsigned nloc = b.st[0], nx = b.st[1];
        if (nloc == 0u) { xcd_barrier_complete(bar, bx_, nloc, nx); b.st[0] = nloc; b.st[1] = nx; }
        const unsigned old = xb_add(&bar[XB_XSUB(bx_)], 1u);
        const unsigned gen = old / nloc;
        if (old + 1u == (gen + 1u) * nloc) {
            __builtin_amdgcn_fence(__ATOMIC_RELEASE, "agent");
            asm volatile("s_waitcnt vmcnt(0)" ::: "memory");
            const unsigned og = xb_add(&bar[XB_TOP], 1u);
            const unsigned tg = og / nx;
            if (og + 1u == (tg + 1u) * nx) xb_add(&bar[XB_TOPGEN], 1u);
            else XB_SPIN(xb_ld(&bar[XB_TOPGEN]) == tg, bar);
            __builtin_amdgcn_fence(__ATOMIC_ACQUIRE, "agent");
            xb_add(&bar[XB_XGEN(bx_)], 1u);
            asm volatile("s_waitcnt vmcnt(0)" ::: "memory");
        } else {
            XB_SPIN(xb_ld(&bar[XB_XGEN(bx_)]) == gen, bar);
            __builtin_amdgcn_fence(__ATOMIC_ACQUIRE, "agent");
            asm volatile("s_waitcnt vmcnt(0)" ::: "memory");
        }
    }
    __syncthreads();
}

struct Frame {
    LAS unsigned char* lds;
    int tid, lane, wave, vcu, G;
    unsigned char* ws;
    const void* const* ka;
    float* out;
};
#define FIN_x(F) ((const float*)(F).ka[opq(0)])
#define FIN_c(F) ((const float*)(F).ka[opq(1)])
#define FIN_positions(F) ((const int*)(F).ka[opq(2)])
#define FIN_mod_w(F) ((const float*)(F).ka[opq(3)])
#define FIN_mod_b(F) ((const float*)(F).ka[opq(4)])
#define FIN_norm_g(F) ((const float*)(F).ka[opq(5)])
#define FIN_w_in(F) ((const float*)(F).ka[opq(6)])
#define FIN_b_f(F) ((const float*)(F).ka[opq(7)])
#define FIN_rel_bias(F) ((const float*)(F).ka[opq(8)])
#define FIN_lam(F) ((const float*)(F).ka[opq(9)])
#define FIN_onorm(F) ((const float*)(F).ka[opq(10)])
#define FIN_w_o(F) ((const float*)(F).ka[opq(11)])
#define FIN_ffn_wg(F) ((const float*)(F).ka[opq(12)])
#define FIN_ffn_wu(F) ((const float*)(F).ka[opq(13)])
#define FIN_ffn_wd(F) ((const float*)(F).ka[opq(14)])
#define FIN_router_w(F) ((const float*)(F).ka[opq(15)])
#define FIN_router_b(F) ((const float*)(F).ka[opq(16)])
#define FIN_exp_wg(F) ((const float*)(F).ka[opq(17)])
#define FIN_exp_wu(F) ((const float*)(F).ka[opq(18)])
#define FIN_exp_wd(F) ((const float*)(F).ka[opq(19)])
template <class T> __device__ __forceinline__ T* wsp(const Frame& F, size_t off) { return (T*)(F.ws + off); }
__device__ __forceinline__ void frame_tid(Frame& F) { F.tid = launder_tid(F.wave); F.lane = F.tid & 63;
    F.ws = (unsigned char*)F.ka[opq(21)]; F.out = (float*)F.ka[opq(20)]; }

__device__ __forceinline__ void transpose_tile(const float* src, size_t ld, int k0, int c0, bf16_t* dst, int dK, int drow0, LAS float* scr, int lane) {
    const float* s = src + (size_t)k0 * ld + c0 + lane;
#pragma unroll 16
    for (int i = 0; i < 64; ++i) scr[i * 65 + lane] = __builtin_nontemporal_load(s + (size_t)i * ld);
    LDS_WAIT(); asm volatile("" ::: "memory");
    const int c = lane & 7;
#pragma unroll
    for (int j = 0; j < 8; ++j) { const int n = (lane >> 3) + 8 * j; const LAS float* p = scr + (8 * c) * 65 + n;
        u32x4 o; o.x = cvt_pk_bf16(p[0 * 65], p[1 * 65]); o.y = cvt_pk_bf16(p[2 * 65], p[3 * 65]); o.z = cvt_pk_bf16(p[4 * 65], p[5 * 65]); o.w = cvt_pk_bf16(p[6 * 65], p[7 * 65]);
        *(u32x4*)(dst + (size_t)(drow0 + n) * dK + k0 + 8 * c) = o; }
    LDS_WAIT(); asm volatile("" ::: "memory");
}
__device__ __forceinline__ void transpose_tile8(const float* src, size_t ld, int k0, int c0, unsigned char* dst, int dK, int drow0, float scl, LAS float* scr, int lane) {
    const int c = lane & 3; u32x4 o[2][4];
#pragma unroll
    for (int hf = 0; hf < 2; ++hf) {
        const float* s = src + (size_t)(k0 + 64 * hf) * ld + c0 + lane;
#pragma unroll 16
        for (int i = 0; i < 64; ++i) scr[i * 65 + lane] = __builtin_nontemporal_load(s + (size_t)i * ld);
        LDS_WAIT(); asm volatile("" ::: "memory");
#pragma unroll
        for (int j = 0; j < 4; ++j) { const int n = (lane >> 2) + 16 * j; const LAS float* p = scr + (16 * c) * 65 + n;
            o[hf][j].x = pk4_fp8(p[0 * 65] * scl, p[1 * 65] * scl, p[2 * 65] * scl, p[3 * 65] * scl); o[hf][j].y = pk4_fp8(p[4 * 65] * scl, p[5 * 65] * scl, p[6 * 65] * scl, p[7 * 65] * scl);
            o[hf][j].z = pk4_fp8(p[8 * 65] * scl, p[9 * 65] * scl, p[10 * 65] * scl, p[11 * 65] * scl); o[hf][j].w = pk4_fp8(p[12 * 65] * scl, p[13 * 65] * scl, p[14 * 65] * scl, p[15 * 65] * scl); }
        LDS_WAIT(); asm volatile("" ::: "memory");
    }
#pragma unroll
    for (int j = 0; j < 4; ++j) { const int n = (lane >> 2) + 16 * j; unsigned char* d = dst + (size_t)(drow0 + n) * dK + k0 + 16 * c;
        *(u32x4*)d = o[0][j]; *(u32x4*)(d + 64) = o[1][j]; }
}
__device__ __forceinline__ void transpose_tile8x(const float* src, size_t ld, int k0, int c0, unsigned char* dst, int dK, int drow0, float scl, LAS float* scr, int lane) {
    const int c = lane & 3; u32x4 o[2][4];
    const float* s = src + (size_t)k0 * ld + c0 + lane;
    float v[64];
#pragma unroll
    for (int i = 0; i < 64; ++i) v[i] = __builtin_nontemporal_load(s + (size_t)i * ld);
#pragma unroll
    for (int hf = 0; hf < 2; ++hf) {
#pragma unroll
        for (int i = 0; i < 64; ++i) scr[i * 65 + lane] = v[i];
        if (hf == 0) {
#pragma unroll
            for (int i = 0; i < 64; ++i) v[i] = __builtin_nontemporal_load(s + (size_t)(64 + i) * ld);
        }
        LDS_WAIT(); asm volatile("" ::: "memory");
#pragma unroll
        for (int j = 0; j < 4; ++j) { const int n = (lane >> 2) + 16 * j; const LAS float* p = scr + (16 * c) * 65 + n;
            o[hf][j].x = pk4_fp8(p[0 * 65] * scl, p[1 * 65] * scl, p[2 * 65] * scl, p[3 * 65] * scl); o[hf][j].y = pk4_fp8(p[4 * 65] * scl, p[5 * 65] * scl, p[6 * 65] * scl, p[7 * 65] * scl);
            o[hf][j].z = pk4_fp8(p[8 * 65] * scl, p[9 * 65] * scl, p[10 * 65] * scl, p[11 * 65] * scl); o[hf][j].w = pk4_fp8(p[12 * 65] * scl, p[13 * 65] * scl, p[14 * 65] * scl, p[15 * 65] * scl); }
        LDS_WAIT(); asm volatile("" ::: "memory");
    }
#pragma unroll
    for (int j = 0; j < 4; ++j) { const int n = (lane >> 2) + 16 * j; unsigned char* d = dst + (size_t)(drow0 + n) * dK + k0 + 16 * c;
        *(u32x4*)d = o[0][j]; *(u32x4*)(d + 64) = o[1][j]; }
}
constexpr int NCV = 896;
__device__ __forceinline__ void expert_conv_item(Frame& F, int k) {
    LAS float* scr = (LAS float*)(F.lds + F.wave * 16640);
    const int lane = launder_tid(F.wave) & 63;
    constexpr int I_F8 = 1792;
    for (int j = 0; j < 3; ++j) { int r = k * 24 + F.wave * 3 + j;
        const int mj = r / I_F8; r -= mj * I_F8; const int e = mj / 3, kind = mj % 3; const size_t eo = (size_t)e * D * DFF;
        const float* src = (const float*)F.ka[opq(17 + kind)] + eo; unsigned char* dst = (kind == 2) ? wsp<unsigned char>(F, WS_ED) + eo : wsp<unsigned char>(F, WS_EGU) + 2 * eo;
        if (kind < 2) { const int kb = r / 112, nb = r % 112, n0 = nb * 64; const int drow0 = 256 * (n0 >> 7) + (n0 & 127) + 128 * kind;
            transpose_tile8x(src, DFF, kb * 128, n0, dst, D, drow0, SW8, scr, lane); }
        else { const int kb = r / 32, nb = r % 32; transpose_tile8x(src, D, kb * 128, nb * 64, dst, DFF, nb * 64, SWD8, scr, lane); } }
}
__device__ __forceinline__ void p0_prologue(Frame& F) {

    LAS float* scr = (LAS float*)(F.lds + F.wave * 16640);
    const int gw = F.vcu * 8 + F.wave, NGW = F.G * 8, lane = F.lane;
    constexpr int I_IN = 32 * 96, I_O = 32 * 32, I_F = 3584, I_F8 = 1792;
    constexpr int NIT = 2 * I_IN + 2 * I_O + (MK_DENSE_FP8 ? 3 * I_F8 : MK_DENSE_DN8 ? 2 * I_F + I_F8 : 3 * I_F) + (MK_XCONV ? 0 : 24 * I_F8);
    for (int it = gw; it < NIT; it += NGW) {
        int r = it;
        if (r < 2 * I_IN) { const int l = r / I_IN; r -= l * I_IN; const int kb = r / 96, nb = r % 96, n0 = nb * 64;
            transpose_tile(FIN_w_in(F) + (size_t)l * D * DIN, DIN, kb * 64, n0 + (n0 >= 2304 ? 6 : 0), wsp<bf16_t>(F, WS_WIN) + (size_t)l * NPROJ * D, D, n0, scr, lane); continue; }
        r -= 2 * I_IN;
        if (r < 2 * I_O) { const int l = r / I_O; r -= l * I_O; const int kb = r / 32, nb = r % 32;
            transpose_tile(FIN_w_o(F) + (size_t)l * D * D, D, kb * 64, nb * 64, wsp<bf16_t>(F, WS_WO) + (size_t)l * D * D, D, nb * 64, scr, lane); continue; }
        r -= 2 * I_O;
#if MK_DENSE_FP8
        if (r < 3 * I_F8) { const int kind = r / I_F8; r -= kind * I_F8; const float* src = (const float*)F.ka[12 + kind]; unsigned char* dst = (kind == 2) ? wsp<unsigned char>(F, WS_WD) : wsp<unsigned char>(F, WS_WGU);
            if (kind < 2) { const int kb = r / 112, nb = r % 112, n0 = nb * 64; const int drow0 = 256 * (n0 >> 7) + (n0 & 127) + 128 * kind;
                transpose_tile8(src, DFF, kb * 128, n0, dst, D, drow0, SW8, scr, lane); }
            else { const int kb = r / 32, nb = r % 32; transpose_tile8(src, D, kb * 128, nb * 64, dst, DFF, nb * 64, SWD8, scr, lane); }
            continue; }
        r -= 3 * I_F8;
#elif MK_DENSE_DN8
        if (r < 2 * I_F) { const int kind = r / I_F; r -= kind * I_F; const float* src = (const float*)F.ka[12 + kind]; bf16_t* dst = wsp<bf16_t>(F, WS_WGU);
            const int kb = r / 112, nb = r % 112, n0 = nb * 64; const int drow0 = 256 * (n0 >> 7) + (n0 & 127) + 128 * kind;
            transpose_tile(src, DFF, kb * 64, n0, dst, D, drow0, scr, lane); continue; }
        r -= 2 * I_F;
        if (r < I_F8) { const int kb = r / 32, nb = r % 32; transpose_tile8((const float*)F.ka[14], D, kb * 128, nb * 64, wsp<unsigned char>(F, WS_WD), DFF, nb * 64, SWD8, scr, lane); continue; }
        r -= I_F8;
#else
        if (r < 3 * I_F) { const int kind = r / I_F; r -= kind * I_F; const float* src = (const float*)F.ka[12 + kind]; bf16_t* dst = (kind == 2) ? wsp<bf16_t>(F, WS_WD) : wsp<bf16_t>(F, WS_WGU);
            if (kind < 2) { const int kb = r / 112, nb = r % 112, n0 = nb * 64; const int drow0 = 256 * (n0 >> 7) + (n0 & 127) + 128 * kind;
                transpose_tile(src, DFF, kb * 64, n0, dst, D, drow0, scr, lane); }
            else { const int kb = r / 32, nb = r % 32; transpose_tile(src, D, kb * 64, nb * 64, dst, DFF, nb * 64, scr, lane); }
            continue; }
        r -= 3 * I_F;
#endif
        { const int mj = r / I_F8; r -= mj * I_F8; const int e = mj / 3, kind = mj % 3; const size_t eo = (size_t)e * D * DFF;
            const float* src = (const float*)F.ka[17 + kind] + eo; unsigned char* dst = (kind == 2) ? wsp<unsigned char>(F, WS_ED) + eo : wsp<unsigned char>(F, WS_EGU) + 2 * eo;
            if (kind < 2) { const int kb = r / 112, nb = r % 112, n0 = nb * 64; const int drow0 = 256 * (n0 >> 7) + (n0 & 127) + 128 * kind;
                transpose_tile8(src, DFF, kb * 128, n0, dst, D, drow0, SW8, scr, lane); }
            else { const int kb = r / 32, nb = r % 32; transpose_tile8(src, D, kb * 128, nb * 64, dst, DFF, nb * 64, SWD8, scr, lane); } }
    }
    {   float* modp = wsp<float>(F, WS_MODP);
        constexpr int NU = 2 * 48 * NMODP;
        for (int u = gw; u < NU; u += NGW) { const int p = u % NMODP, cg = (u / NMODP) % 48, l = u / (NMODP * 48);
            const float* w = FIN_mod_w(F) + (size_t)l * D * 6 * D + (size_t)(p * 128) * 6 * D + cg * 256 + 4 * lane; const float* cvp = FIN_c(F) + p * 128;
            f32x4 a = {0.f, 0.f, 0.f, 0.f};
#pragma unroll 16
            for (int d = 0; d < 128; ++d) { const float cv = cvp[d]; const float sv = cv / (1.0f + __expf(-cv)); a += *(const f32x4*)(w + (size_t)d * 6 * D) * sv; }
            float* mo = modp + ((size_t)l * 6 * D + cg * 256 + 4 * lane) * NMODP + p; mo[0] = a.x; mo[NMODP] = a.y; mo[2 * NMODP] = a.z; mo[3 * NMODP] = a.w; }
    }
    {   float* rope = wsp<float>(F, WS_ROPE);
        const int gt = (F.vcu * 8 + F.wave) * 64 + lane, NT = F.G * 512; const int* posp = FIN_positions(F);
        for (int i = gt; i < S * 8; i += NT) { const int t = i >> 3, j = i & 7;
            const float inv = (float)exp2(-(double)j * 0.125 * 18.931568569324174);
            const float ang = (float)posp[t] * inv;
            const double a = (double)ang, kq = rint(a * 0.15915494309189535), r = (a - kq * 6.283185307179586) - kq * 2.4492935982947064e-16;
            const double r2 = r * r; double sn = 0.0, cs = 0.0;
            { double term = r; sn = r;
#pragma unroll
              for (int n = 1; n < 14; ++n) { term *= -r2 / (double)((2 * n) * (2 * n + 1)); sn += term; } }
            { double term = 1.0; cs = 1.0;
#pragma unroll
              for (int n = 1; n < 14; ++n) { term *= -r2 / (double)((2 * n - 1) * (2 * n)); cs += term; } }
            rope[(size_t)t * 16 + j] = (float)cs; rope[(size_t)t * 16 + 8 + j] = (float)sn; }
    }
    if (blockIdx.x == 0) { int* tl = wsp<int>(F, WS_TILES); for (int i = F.tid; i < 256; i += 512) tl[i] = (i == 0) ? 64 : 0; }
}

__device__ __forceinline__ float modv(const Frame& F, int l, int k, int c) {
    const f32x4* mp = (const f32x4*)(wsp<float>(F, WS_MODP) + ((size_t)l * 6 * D + k * D + c) * NMODP);
    const f32x4 a = mp[0], b = mp[1], c4 = mp[2], d = mp[3];
    const float s = FIN_mod_b(F)[l * 6 * D + k * D + c] + (((a.x + a.y) + (a.z + a.w)) + ((b.x + b.y) + (b.z + b.w))) + (((c4.x + c4.y) + (c4.z + c4.w)) + ((d.x + d.y) + (d.z + d.w)));
    return s;
}
template <int RMODE>
__device__ __forceinline__ void row_phase(Frame& F, int l, bool dry = false) {
    constexpr bool HAS_Y = RMODE != 0, HAS_H = RMODE != 4, Y_MOE = RMODE == 4;
    constexpr int NX = (RMODE == 0 || RMODE == 1) ? 6 : (RMODE == 3 ? 8 : 0);
    LAS float* L = (LAS float*)F.lds;
    LAS float* vB = L; LAS float* vA = L + 2048; LAS float* vS = L + 4096; LAS float* wX = L + 6144;
#pragma unroll
    for (int c = F.tid; c < D; c += 512) {
        if (RMODE == 0 || RMODE == 1) { vA[c] = FIN_norm_g(F)[(l * 4 + 0) * D + c] * (1.0f + modv(F, l, 1, c)); vS[c] = modv(F, l, 0, c);
            if (RMODE == 1) vB[c] = modv(F, l - 1, 5, c) * FIN_norm_g(F)[((l - 1) * 4 + 3) * D + c];
#pragma unroll
            for (int a = 0; a < 6; ++a) wX[a * D + c] = FIN_w_in(F)[(size_t)l * D * DIN + (size_t)c * DIN + 2304 + a]; }
        if (RMODE == 2 || RMODE == 3) { vB[c] = modv(F, l, 2, c) * FIN_norm_g(F)[(l * 4 + 1) * D + c]; vA[c] = FIN_norm_g(F)[(l * 4 + 2) * D + c] * (1.0f + modv(F, l, 4, c)); vS[c] = modv(F, l, 3, c);
            if (RMODE == 3) {
#pragma unroll
                for (int e = 0; e < 8; ++e) wX[e * D + c] = FIN_router_w(F)[c * 8 + e]; } }
        if (RMODE == 4) vB[c] = modv(F, l, 5, c) * FIN_norm_g(F)[(l * 4 + 3) * D + c];
    }
    __syncthreads();
    const int gw = F.vcu * 8 + F.wave, NGW = F.G * 8, lane = F.lane;
    constexpr bool XIN_F32 = (RMODE == 0 || RMODE == 2), XOUT_F32 = (RMODE == 4);
    const float* xin = FIN_x(F); const bf16_t* xinb = wsp<bf16_t>(F, WS_XB); const float* bfp = FIN_b_f(F) + l * 6; const float* rbp = FIN_router_b(F);
    const bf16_t* Y = (RMODE == 4) ? wsp<bf16_t>(F, WS_YP) : wsp<bf16_t>(F, WS_Y);
    bool ysplit = false; if (RMODE == 4) { const int ntl_ = __builtin_amdgcn_readfirstlane((wsp<int>(F, WS_TILES) + 256)[0]); ysplit = (F.G == 256 && ntl_ >= 128 && ntl_ < 160); }
    bf16_t* H = dry ? wsp<bf16_t>(F, WS_BIG + 160 * MiB) : wsp<bf16_t>(F, WS_H); float* xout = dry ? wsp<float>(F, WS_BIG) : F.out; bf16_t* xoutb = dry ? wsp<bf16_t>(F, WS_BIG) : wsp<bf16_t>(F, WS_XB);
#define COLJ(j) (8 * lane + 512 * ((j) >> 1) + 4 * ((j) & 1))
    f32x4 pxf[8]; u32x4 pxb[4], pyb[4];
    auto issue_row = [&](int tt) {
        if constexpr (XIN_F32) {
#pragma unroll
            for (int j = 0; j < 8; ++j) pxf[j] = __builtin_nontemporal_load((const f32x4*)(xin + (size_t)tt * D + COLJ(j))); }
        else {
#pragma unroll
            for (int jj = 0; jj < 4; ++jj) pxb[jj] = __builtin_nontemporal_load((const u32x4*)(xinb + (size_t)tt * D + 8 * lane + 512 * jj)); }
        if constexpr (HAS_Y && !Y_MOE) {
#pragma unroll
            for (int jj = 0; jj < 4; ++jj) pyb[jj] = __builtin_nontemporal_load((const u32x4*)(Y + (size_t)tt * D + 8 * lane + 512 * jj)); } };
    if (gw < S) issue_row(gw);
    for (int t = gw; t < S; t += NGW) {
        f32x4 xv[8]; u32x4 cyb[4];
        if constexpr (XIN_F32) {
#pragma unroll
            for (int j = 0; j < 8; ++j) xv[j] = pxf[j]; }
        else {
#pragma unroll
            for (int jj = 0; jj < 4; ++jj) { const u32x4 a = pxb[jj]; xv[2 * jj] = (f32x4){bf_lo(a.x), bf_hi(a.x), bf_lo(a.y), bf_hi(a.y)}; xv[2 * jj + 1] = (f32x4){bf_lo(a.z), bf_hi(a.z), bf_lo(a.w), bf_hi(a.w)}; } }
        if constexpr (HAS_Y && !Y_MOE) {
#pragma unroll
            for (int jj = 0; jj < 4; ++jj) cyb[jj] = pyb[jj]; }
        if (t + NGW < S) issue_row(t + NGW);
        if constexpr (HAS_Y) {
            f32x4 yv[8];
            if constexpr (Y_MOE) {
                const int s1 = wsp<int>(F, WS_TOKS)[2 * t], s2 = wsp<int>(F, WS_TOKS)[2 * t + 1]; const float g1 = wsp<float>(F, WS_TOKG)[2 * t], g2 = wsp<float>(F, WS_TOKG)[2 * t + 1];
                auto yrow2 = [&](int sl, int jj, f32x4& lo, f32x4& hi) {
                    if (ysplit && (sl >> 8) >= 128) { const float* q = wsp<float>(F, WS_YPS) + (size_t)(((sl >> 8) - 128) * 256 + (sl & 255)) * D + 8 * lane + 512 * jj; constexpr size_t KS = (size_t)8 * 256 * D;
                        lo = ((*(const f32x4*)q + *(const f32x4*)(q + KS)) + (*(const f32x4*)(q + 2 * KS) + *(const f32x4*)(q + 3 * KS))) * (1.0f / (SA8 * SWD8));
                        hi = ((*(const f32x4*)(q + 4) + *(const f32x4*)(q + 4 + KS)) + (*(const f32x4*)(q + 4 + 2 * KS) + *(const f32x4*)(q + 4 + 3 * KS))) * (1.0f / (SA8 * SWD8)); }
                    else { const u32x4 a = __builtin_nontemporal_load((const u32x4*)(Y + (size_t)sl * D + 8 * lane + 512 * jj));
                        lo = (f32x4){bf_lo(a.x), bf_hi(a.x), bf_lo(a.y), bf_hi(a.y)}; hi = (f32x4){bf_lo(a.z), bf_hi(a.z), bf_lo(a.w), bf_hi(a.w)}; } };
#pragma unroll
                for (int jj = 0; jj < 4; ++jj) { f32x4 a0, a1, b0, b1; yrow2(s1, jj, a0, a1); yrow2(s2, jj, b0, b1); yv[2 * jj] = a0 * g1 + b0 * g2; yv[2 * jj + 1] = a1 * g1 + b1 * g2; }
            } else {
#pragma unroll
                for (int jj = 0; jj < 4; ++jj) { const u32x4 a = cyb[jj]; yv[2 * jj] = (f32x4){bf_lo(a.x), bf_hi(a.x), bf_lo(a.y), bf_hi(a.y)}; yv[2 * jj + 1] = (f32x4){bf_lo(a.z), bf_hi(a.z), bf_lo(a.w), bf_hi(a.w)}; }
            }
            float ss = 0.f;
#pragma unroll
            for (int j = 0; j < 8; ++j) ss += (yv[j].x * yv[j].x + yv[j].y * yv[j].y) + (yv[j].z * yv[j].z + yv[j].w * yv[j].w);
            const float rstd = rsqrtf(wave_sum(ss) * (1.0f / D) + EPS);
            u32x2 wprev = {0u, 0u};
#pragma unroll
            for (int j = 0; j < 8; ++j) { const f32x4 gb = *(const LAS f32x4*)(vB + COLJ(j)); xv[j] += gb * (yv[j] * rstd);
                if constexpr (XOUT_F32) __builtin_nontemporal_store(xv[j], (f32x4*)(xout + (size_t)t * D + COLJ(j)));
                else { u32x2 w; w.x = cvt_pk_bf16(xv[j].x, xv[j].y); w.y = cvt_pk_bf16(xv[j].z, xv[j].w); if (j & 1) { u32x4 w4; w4.x = wprev.x; w4.y = wprev.y; w4.z = w.x; w4.w = w.y; *(u32x4*)(xoutb + (size_t)t * D + 8 * lane + 512 * (j >> 1)) = w4; } wprev = w;
                    xv[j] = (f32x4){bf_lo(w.x), bf_hi(w.x), bf_lo(w.y), bf_hi(w.y)}; } }
        }
        if constexpr (HAS_H) {
            float ss = 0.f;
#pragma unroll
            for (int j = 0; j < 8; ++j) ss += (xv[j].x * xv[j].x + xv[j].y * xv[j].y) + (xv[j].z * xv[j].z + xv[j].w * xv[j].w);
            const float rstd = rsqrtf(wave_sum(ss) * (1.0f / D) + EPS);
            float dots[NX > 0 ? NX : 1];
#pragma unroll
            for (int e = 0; e < NX; ++e) dots[e] = 0.f;
            u32x2 hprev = {0u, 0u};
#pragma unroll
            for (int j = 0; j < 8; ++j) { const f32x4 ga = *(const LAS f32x4*)(vA + COLJ(j)), sh = *(const LAS f32x4*)(vS + COLJ(j));
                const f32x4 hv = (xv[j] * rstd) * ga + sh;
                if constexpr (RMODE == 2 && MK_DENSE_FP8) { *(unsigned*)((unsigned char*)H + (size_t)t * D + COLJ(j)) = pk4_fp8(hv.x * SH8, hv.y * SH8, hv.z * SH8, hv.w * SH8); }
                else { u32x2 w; w.x = cvt_pk_bf16(hv.x, hv.y); w.y = cvt_pk_bf16(hv.z, hv.w); if (j & 1) { u32x4 w4; w4.x = hprev.x; w4.y = hprev.y; w4.z = w.x; w4.w = w.y; *(u32x4*)(H + (size_t)t * D + 8 * lane + 512 * (j >> 1)) = w4; } hprev = w; }
#pragma unroll
                for (int e = 0; e < NX; ++e) { const f32x4 wv = *(const LAS f32x4*)(wX + e * D + COLJ(j)); dots[e] += (hv.x * wv.x + hv.y * wv.y) + (hv.z * wv.z + hv.w * wv.w); } }
#pragma unroll
            for (int e = 0; e < NX; ++e) dots[e] = wave_sum(dots[e]);
            if constexpr (NX == 6) {
                if (lane < 6) { float z = 0.f;
#pragma unroll
                    for (int e = 0; e < 6; ++e) z = (lane == e) ? dots[e] : z;
                    z += bfp[lane];
                    const float ls = fminf(z, 0.f) - __builtin_amdgcn_logf(1.0f + __builtin_amdgcn_exp2f(-fabsf(z) * LOG2E)) * 0.6931471805599453f;
                    wsp<float>(F, WS_LOGF)[(size_t)t * 8 + lane] = ls; }
            }
            if constexpr (NX == 8) {
                if (lane == 0) { float v[8];
#pragma unroll
                    for (int e = 0; e < 8; ++e) v[e] = dots[e] + rbp[e];
                    int i1 = 0; float v1 = v[0];
#pragma unroll
                    for (int e = 1; e < 8; ++e) if (v[e] > v1) { v1 = v[e]; i1 = e; }
                    int i2 = -1; float v2 = -3.0e38f;
#pragma unroll
                    for (int e = 0; e < 8; ++e) if (e != i1 && v[e] > v2) { v2 = v[e]; i2 = e; }
                    const float e2 = __expf(v2 - v1), g1 = 1.0f / (1.0f + e2), g2 = e2 * g1;
                    wsp<unsigned>(F, WS_TOKE)[t] = (unsigned)i1 | ((unsigned)i2 << 8);
                    wsp<float>(F, WS_TOKG)[2 * t] = g1; wsp<float>(F, WS_TOKG)[2 * t + 1] = g2; }
            }
        }
    }
    __syncthreads();
}

__device__ __forceinline__ void scan_head(Frame& F, int a) {
    const int tid = launder_tid(F.wave);
    LAS double* sd = (LAS double*)F.lds; LAS double* sbase = sd + 512;
    const float* lf = wsp<float>(F, WS_LOGF);
    double loc = 0.0;
    for (int i = 0; i < 32; ++i) loc += (double)lf[(size_t)(32 * tid + i) * 8 + a];
    sd[tid] = loc; __syncthreads();
    for (int o = 1; o < 512; o <<= 1) { const double v = (tid >= o) ? sd[tid - o] : 0.0; __syncthreads(); sd[tid] += v; __syncthreads(); }
    const double excl = sd[tid] - loc;
    if ((tid & 7) == 0) sbase[tid >> 3] = excl + (double)lf[(size_t)(32 * tid) * 8 + a];
    __syncthreads();
    const double bs = sbase[tid >> 3]; double run = excl;
    float* frel = wsp<float>(F, WS_FREL) + (size_t)a * S; double* fd = wsp<double>(F, WS_FD) + (size_t)a * S;
    for (int i = 0; i < 32; ++i) { const int t = 32 * tid + i; run += (double)lf[(size_t)t * 8 + a]; fd[t] = run; frel[t] = (float)(run - bs); }
    if (tid < 64) { const double b_ = sbase[tid]; const float bh_ = (float)b_; wsp<f32x2>(F, WS_FBASE)[a * 64 + tid] = (f32x2){bh_, (float)(b_ - (double)bh_)}; }
    __syncthreads();
}

__device__ __forceinline__ void ld8(const bf16_t* p, float (&f)[8]) { const u32x4 w = *(const u32x4*)p; f[0] = bf_lo(w.x); f[1] = bf_hi(w.x); f[2] = bf_lo(w.y); f[3] = bf_hi(w.y); f[4] = bf_lo(w.z); f[5] = bf_hi(w.z); f[6] = bf_lo(w.w); f[7] = bf_hi(w.w); }
#if MK_NAIVE_ATTN
template <int MODE>
__device__ __forceinline__ void naive_attn_row(Frame& F, int l, int h, int t, float lamf, float laminit) {
    const int lane = F.lane, g = lane >> 4, i = lane & 15;
    const bf16_t* P = wsp<bf16_t>(F, WS_PROJ);
    const int qcol = (MODE == 0 ? QA : MODE == 1 ? QB_ : QC) + h * HD, kcol = (MODE == 0 ? KA : MODE == 1 ? KB_ : KC) + h * HD, vcol = (MODE == 0 ? VA : MODE == 1 ? VB_ : VC) + h * HD;
    float qf[8]; ld8(P + (size_t)t * NPROJ + qcol + 8 * i, qf);
    const int cq = t >> 6;
    const int s_lo = (MODE == 1) ? (cq >= 8 ? (cq - 8) * 64 : 0) : 0, s_hi = (MODE == 0) ? t : cq * 64 + 63;
    float m0 = -1e30f, l0 = 0.f, o0[8], m1 = -1e30f, l1 = 0.f, o1[8];
#pragma unroll
    for (int j = 0; j < 8; ++j) { o0[j] = 0.f; o1[j] = 0.f; }
    const double* fd = wsp<double>(F, WS_FD) + (size_t)h * S; const double ft = (MODE == 0) ? fd[t] : 0.0;
    const float* rb = FIN_rel_bias(F) + (size_t)(l * NHB + h) * 513;
#pragma unroll 2
    for (int s4 = s_lo; s4 <= s_hi; s4 += 4) {
        const int s = s4 + g; const bool valid = s <= s_hi; const int sc = valid ? s : s_hi;
        float kf[8], vf[8]; ld8(P + (size_t)sc * NPROJ + kcol + 8 * i, kf); ld8(P + (size_t)sc * NPROJ + vcol + 8 * i, vf);
        float d = 0.f;
#pragma unroll
        for (int j = 0; j < 8; ++j) d += qf[j] * kf[j];
        d += __shfl_xor(d, 1); d += __shfl_xor(d, 2); d += __shfl_xor(d, 4);
        if constexpr (MODE != 2) {
            d += __shfl_xor(d, 8);
            float bias;
            if constexpr (MODE == 0) bias = (float)(ft - fd[sc]) * LOG2E;
            else { int dd = t - sc; dd = dd < -256 ? -256 : (dd > 256 ? 256 : dd); bias = rb[dd + 256] * LOG2E; }
            const float sv = valid ? d + bias : -__builtin_inff();
            const float mn = fmaxf(m0, sv), al = __builtin_amdgcn_exp2f(m0 - mn), p = __builtin_amdgcn_exp2f(sv - mn);
            m0 = mn; l0 = l0 * al + p;
#pragma unroll
            for (int j = 0; j < 8; ++j) o0[j] = o0[j] * al + p * vf[j];
        } else {
            const float other = __shfl_xor(d, 8);
            const float sa = valid ? ((i < 8) ? d : other) : -__builtin_inff(), sb = valid ? ((i < 8) ? other : d) : -__builtin_inff();
            { const float mn = fmaxf(m0, sa), al = __builtin_amdgcn_exp2f(m0 - mn), p = __builtin_amdgcn_exp2f(sa - mn); m0 = mn; l0 = l0 * al + p;
#pragma unroll
              for (int j = 0; j < 8; ++j) o0[j] = o0[j] * al + p * vf[j]; }
            { const float mn = fmaxf(m1, sb), al = __builtin_amdgcn_exp2f(m1 - mn), p = __builtin_amdgcn_exp2f(sb - mn); m1 = mn; l1 = l1 * al + p;
#pragma unroll
              for (int j = 0; j < 8; ++j) o1[j] = o1[j] * al + p * vf[j]; }
        }
    }
#pragma unroll
    for (int sh = 16; sh < 64; sh <<= 1) {
        { const float m2 = __shfl_xor(m0, sh), l2 = __shfl_xor(l0, sh), mn = fmaxf(m0, m2), a = __builtin_amdgcn_exp2f(m0 - mn), b = __builtin_amdgcn_exp2f(m2 - mn);
          l0 = l0 * a + l2 * b; m0 = mn;
#pragma unroll
          for (int j = 0; j < 8; ++j) { const float o2 = __shfl_xor(o0[j], sh); o0[j] = o0[j] * a + o2 * b; } }
        if constexpr (MODE == 2) { const float m2 = __shfl_xor(m1, sh), l2 = __shfl_xor(l1, sh), mn = fmaxf(m1, m2), a = __builtin_amdgcn_exp2f(m1 - mn), b = __builtin_amdgcn_exp2f(m2 - mn);
          l1 = l1 * a + l2 * b; m1 = mn;
#pragma unroll
          for (int j = 0; j < 8; ++j) { const float o2 = __shfl_xor(o1[j], sh); o1[j] = o1[j] * a + o2 * b; } }
    }
    float r[8]; float ss = 0.f;
    const float il0 = 1.0f / l0, il1 = (MODE == 2) ? lamf / l1 : 0.f;
#pragma unroll
    for (int j = 0; j < 8; ++j) { r[j] = o0[j] * il0 - ((MODE == 2) ? o1[j] * il1 : 0.f); ss += r[j] * r[j]; }
    ss += __shfl_xor(ss, 1); ss += __shfl_xor(ss, 2); ss += __shfl_xor(ss, 4); ss += __shfl_xor(ss, 8);
    const float rstd = rsqrtf(ss * (1.0f / HD) + EPS) * ((MODE == 2) ? (1.0f - laminit) : 1.0f);
    const float* on = FIN_onorm(F) + (size_t)(l * 3 + MODE) * HD + 8 * i;
    if (g == 0) { const int ocol = (MODE == 0 ? 0 : MODE == 1 ? 768 : 1536) + h * HD + 8 * i;
        u32x4 w; w.x = cvt_pk_bf16(r[0] * rstd * on[0], r[1] * rstd * on[1]); w.y = cvt_pk_bf16(r[2] * rstd * on[2], r[3] * rstd * on[3]);
        w.z = cvt_pk_bf16(r[4] * rstd * on[4], r[5] * rstd * on[5]); w.w = cvt_pk_bf16(r[6] * rstd * on[6], r[7] * rstd * on[7]);
        *(u32x4*)(wsp<bf16_t>(F, WS_O) + (size_t)t * D + ocol) = w; }
}
__device__ __forceinline__ void naive_attn_phase(Frame& F, int l) {
    const int gw = F.vcu * 8 + F.wave, NGW = F.G * 8, lane = F.lane;
    const float laminit = 0.8f - 0.6f * expf(-0.3f * (float)l);
    const float* lm = FIN_lam(F) + l * 4 * 64;
    const float sa = wave_sum(lm[lane] * lm[64 + lane]), sb = wave_sum(lm[128 + lane] * lm[192 + lane]);
    const float lamf = expf(sa) - expf(sb) + laminit;
    for (int it = gw; it < S * 16; it += NGW) { const int t = it >> 4, hh = it & 15;
        if (hh < 6) naive_attn_row<0>(F, l, hh, t, lamf, laminit);
        else if (hh < 12) naive_attn_row<1>(F, l, hh - 6, t, lamf, laminit);
        else naive_attn_row<2>(F, l, hh - 12, t, lamf, laminit); }
}


#endif
namespace fa {
typedef float f32x16 __attribute__((ext_vector_type(16)));
typedef short s16x4 __attribute__((ext_vector_type(4)));
constexpr int SHM_V = 16384, SHM_K = 16384;
constexpr int NBUF = 3;
constexpr int OFF_V = 0, OFF_K = NBUF * SHM_V, OFF_WS = OFF_K + NBUF * SHM_K, OFF_BA = OFF_WS + 2048, OFF_TB = OFF_BA + NBUF * 256, ATT_LDS = OFF_TB + 2064;
constexpr float THR = 8.f;
constexpr float THR2 = MK_PV8 ? 2.f : 8.f;
constexpr float PSH = 3.f;
constexpr float SP8 = 64.f, SV8 = 16.f;
#define KSWZ(row, colB) ((row) * 256 + ((colB) ^ (((row) & 7) << 4)))
#define SBAR() __builtin_amdgcn_sched_barrier(0)
__device__ __forceinline__ int v_st(int k, int c) { const int kk = (k & ~0xC) | ((k & 4) << 1) | ((k & 8) >> 1); return ((kk >> 3) * 4 + (c >> 5)) * 512 + ((kk & 7) * 32 + (c & 31)) * 2; }
__device__ __forceinline__ int v_rd_base(int lane) { return ((lane & 3) << 3) | (((lane >> 2) & 3) << 6) | (((lane >> 4) & 1) << 5) | (((lane >> 5) & 1) << 8); }
constexpr int v_rd_off(int d0, int ks, int half) { return d0 * 512 + ks * 4096 + half * 2048; }
__device__ __forceinline__ int crow(int r, int hi) { return (r & 3) + 8 * (r >> 2) + 4 * hi; }
__device__ __forceinline__ unsigned cvtpk(float lo, float hi) { unsigned r; asm volatile("v_cvt_pk_bf16_f32 %0, %1, %2" : "=v"(r) : "v"(lo), "v"(hi)); return r; }
__device__ __forceinline__ void mask_causal(f32x16& p0, f32x16& p1, int dq) {
    const float NEG = -__builtin_inff();
#pragma unroll
    for (int r = 0; r < 16; ++r) { const int c = (r & 3) + 8 * (r >> 2); if (dq - c < 0) p0[r] = NEG; if (dq - c - 32 < 0) p1[r] = NEG; }
}
__device__ __forceinline__ void partialSM(f32x16& p0, f32x16& p1, float& m_reg, float& mn, float& alpha) {
    float pmax = p0[0];
#pragma unroll
    for (int r = 1; r < 16; ++r) pmax = fmaxf(pmax, p0[r]);
#pragma unroll
    for (int r = 0; r < 16; ++r) pmax = fmaxf(pmax, p1[r]);
    { auto rr = __builtin_amdgcn_permlane32_swap(__float_as_uint(pmax), __float_as_uint(pmax), false, false); pmax = fmaxf(__uint_as_float(rr[0]), __uint_as_float(rr[1])); }
    if (__builtin_expect(__all((pmax - m_reg) <= THR), 1)) { mn = m_reg; alpha = 1.f; }
    else { mn = fmaxf(m_reg, pmax); alpha = __builtin_amdgcn_exp2f(m_reg - mn); m_reg = mn; }
#pragma unroll
    for (int r = 0; r < 16; ++r) p0[r] = p0[r] - mn;
#pragma unroll
    for (int r = 0; r < 16; ++r) p1[r] = p1[r] - mn;
#pragma unroll
    for (int r = 0; r < 16; ++r) p0[r] = __builtin_amdgcn_exp2f(p0[r]);
}
__device__ __forceinline__ void partialSM_rel(f32x16& p0, f32x16& p1, float& m_reg, float& alpha, f32x16& negm) {
    float pmax = p0[0];
#pragma unroll
    for (int r = 1; r < 16; ++r) pmax = fmaxf(pmax, p0[r]);
#pragma unroll
    for (int r = 0; r < 16; ++r) pmax = fmaxf(pmax, p1[r]);
    { auto rr = __builtin_amdgcn_permlane32_swap(__float_as_uint(pmax), __float_as_uint(pmax), false, false); pmax = fmaxf(__uint_as_float(rr[0]), __uint_as_float(rr[1])); }
    if (__builtin_expect(__all(pmax <= THR2), 1)) { alpha = 1.f; }
    else { const float d = fmaxf(pmax, 0.f); m_reg += d; alpha = __builtin_amdgcn_exp2f(-d);
#pragma unroll
        for (int r = 0; r < 16; ++r) { p0[r] -= d; p1[r] -= d; }
#pragma unroll
        for (int r = 0; r < 16; ++r) negm[r] = -m_reg;
        asm volatile("" : "+v"(negm)); }
#pragma unroll
    for (int r = 0; r < 16; ++r) p0[r] = __builtin_amdgcn_exp2f(p0[r]);
}
__device__ __forceinline__ void finishSM(f32x16& p0, f32x16& p1, float alpha, float& l_reg, bf16x8& pa0, bf16x8& pa1, bf16x8& pa2, bf16x8& pa3) {
#pragma unroll
    for (int r = 0; r < 16; ++r) p1[r] = __builtin_amdgcn_exp2f(p1[r]);
    float ps = 0;
#pragma unroll
    for (int r = 0; r < 16; ++r) ps += p0[r];
#pragma unroll
    for (int r = 0; r < 16; ++r) ps += p1[r];
    { auto rr = __builtin_amdgcn_permlane32_swap(__float_as_uint(ps), __float_as_uint(ps), false, false); ps = __uint_as_float(rr[0]) + __uint_as_float(rr[1]); }
    l_reg = l_reg * alpha + ps;
#define PK4(P, B_, OUT) do { unsigned a0 = cvtpk(P[B_+0], P[B_+1]), a1 = cvtpk(P[B_+2], P[B_+3]); unsigned b0 = cvtpk(P[B_+4], P[B_+5]), b1 = cvtpk(P[B_+6], P[B_+7]); \
        auto r0 = __builtin_amdgcn_permlane32_swap(a0, b0, false, false); auto r1 = __builtin_amdgcn_permlane32_swap(a1, b1, false, false); \
        u32x4 w = {r0[0], r1[0], r0[1], r1[1]}; OUT = *reinterpret_cast<bf16x8*>(&w); } while (0)
    PK4(p0, 0, pa0); PK4(p0, 8, pa1); PK4(p1, 0, pa2); PK4(p1, 8, pa3);
#undef PK4
}
__device__ __forceinline__ void finishSM8(f32x16& p0, f32x16& p1, float alpha, float& l_reg, i32x8& p8) {
#pragma unroll
    for (int r = 0; r < 16; ++r) p1[r] = __builtin_amdgcn_exp2f(p1[r]);
    float ps = 0;
#pragma unroll
    for (int r = 0; r < 16; ++r) ps += p0[r];
#pragma unroll
    for (int r = 0; r < 16; ++r) ps += p1[r];
    { auto rr = __builtin_amdgcn_permlane32_swap(__float_as_uint(ps), __float_as_uint(ps), false, false); ps = __uint_as_float(rr[0]) + __uint_as_float(rr[1]); }
    l_reg = l_reg * alpha + ps;
#pragma unroll
    for (int d = 0; d < 4; ++d) { int w = 0; w = __builtin_amdgcn_cvt_pk_fp8_f32(p0[4 * d] * SP8, p0[4 * d + 1] * SP8, w, false); w = __builtin_amdgcn_cvt_pk_fp8_f32(p0[4 * d + 2] * SP8, p0[4 * d + 3] * SP8, w, true); p8[d] = w;
        int x = 0; x = __builtin_amdgcn_cvt_pk_fp8_f32(p1[4 * d] * SP8, p1[4 * d + 1] * SP8, x, false); x = __builtin_amdgcn_cvt_pk_fp8_f32(p1[4 * d + 2] * SP8, p1[4 * d + 3] * SP8, x, true); p8[4 + d] = x; }
}
__device__ __forceinline__ void partialSM_first8(f32x16& p0, f32x16& p1, float& m_reg) {
    float pmax = p0[0];
#pragma unroll
    for (int r = 1; r < 16; ++r) pmax = fmaxf(pmax, p0[r]);
#pragma unroll
    for (int r = 0; r < 16; ++r) pmax = fmaxf(pmax, p1[r]);
    { auto rr = __builtin_amdgcn_permlane32_swap(__float_as_uint(pmax), __float_as_uint(pmax), false, false); pmax = fmaxf(__uint_as_float(rr[0]), __uint_as_float(rr[1])); }
    m_reg = pmax - PSH;
#pragma unroll
    for (int r = 0; r < 16; ++r) { p0[r] -= m_reg; p1[r] -= m_reg; }
#pragma unroll
    for (int r = 0; r < 16; ++r) p0[r] = __builtin_amdgcn_exp2f(p0[r]);
}
__device__ __forceinline__ void partialSM_rel8(f32x16& p0, f32x16& p1, float& m_reg, float& alpha, f32x16& negm) {
    float pmax = p0[0];
#pragma unroll
    for (int r = 1; r < 16; ++r) pmax = fmaxf(pmax, p0[r]);
#pragma unroll
    for (int r = 0; r < 16; ++r) pmax = fmaxf(pmax, p1[r]);
    { auto rr = __builtin_amdgcn_permlane32_swap(__float_as_uint(pmax), __float_as_uint(pmax), false, false); pmax = fmaxf(__uint_as_float(rr[0]), __uint_as_float(rr[1])); }
    if (__builtin_expect(__all(pmax <= 8.f), 1)) { alpha = 1.f; }
    else { const float d = pmax > 8.f ? pmax - PSH : 0.f; m_reg += d; alpha = __builtin_amdgcn_exp2f(-d);
#pragma unroll
        for (int r = 0; r < 16; ++r) { p0[r] -= d; p1[r] -= d; }
#pragma unroll
        for (int r = 0; r < 16; ++r) negm[r] = -m_reg;
        asm volatile("" : "+v"(negm)); }
#pragma unroll
    for (int r = 0; r < 16; ++r) p0[r] = __builtin_amdgcn_exp2f(p0[r]);
}
__device__ __forceinline__ void finishLS8(f32x16& p0, f32x16& p1, i32x8& p8) {
#pragma unroll
    for (int r = 0; r < 16; ++r) p1[r] = __builtin_amdgcn_exp2f(p1[r]);
#pragma unroll
    for (int d = 0; d < 4; ++d) { int w = 0; w = __builtin_amdgcn_cvt_pk_fp8_f32(p0[4 * d], p0[4 * d + 1], w, false); w = __builtin_amdgcn_cvt_pk_fp8_f32(p0[4 * d + 2], p0[4 * d + 3], w, true); p8[d] = w;
        int x = 0; x = __builtin_amdgcn_cvt_pk_fp8_f32(p1[4 * d], p1[4 * d + 1], x, false); x = __builtin_amdgcn_cvt_pk_fp8_f32(p1[4 * d + 2], p1[4 * d + 3], x, true); p8[4 + d] = x; }
}
__device__ __forceinline__ void cvt16(const f32x16& p0, const f32x16& p1, i32x8& p8) {
#pragma unroll
    for (int d = 0; d < 4; ++d) { int w = p8[d]; w = __builtin_amdgcn_cvt_pk_fp8_f32(p0[4 * d], p0[4 * d + 1], w, false); w = __builtin_amdgcn_cvt_pk_fp8_f32(p0[4 * d + 2], p0[4 * d + 3], w, true); p8[d] = w;
        int x = p8[4 + d]; x = __builtin_amdgcn_cvt_pk_fp8_f32(p1[4 * d], p1[4 * d + 1], x, false); x = __builtin_amdgcn_cvt_pk_fp8_f32(p1[4 * d + 2], p1[4 * d + 3], x, true); p8[4 + d] = x; }
}
__device__ __forceinline__ float max16(const f32x16& p) {
    float m = fmaxf(p[0], p[1]);
#pragma unroll
    for (int r = 2; r < 16; r += 2) m = fmaxf(fmaxf(m, p[r]), p[r + 1]);
    return m;
}
__device__ __forceinline__ void pv8(f32x16* o, LAS const char* vb, const i32x8& p8, bool act) {
    if (!act) return;
#pragma unroll
    for (int d0 = 0; d0 < 4; ++d0) { i32x8 v8; v8.lo = *(LAS const i32x4*)(vb + d0 * 2560); v8.hi = *(LAS const i32x4*)(vb + d0 * 2560 + 16);
        o[d0] = __builtin_amdgcn_mfma_scale_f32_32x32x64_f8f6f4(p8, v8, o[d0], 0, 0, 0, 0, 0, 0); }
}
__device__ __forceinline__ void pv_tile(f32x16* o, int vb0, bf16x8 pa0, bf16x8 pa1, bf16x8 pa2, bf16x8 pa3, bool act) {
    if (!act) return;
#define TRRD(dst, off) asm volatile("ds_read_b64_tr_b16 %0, %1 offset:%2" : "=&v"(dst) : "v"(vb0), "i"(off) : "memory")
#define PV_D0(d0) do { s16x4 l0, l1, l2, l3, h0, h1, h2, h3; constexpr int b_ = v_rd_off(d0, 0, 0); \
        TRRD(l0, b_); TRRD(h0, b_ + 2048); TRRD(l1, b_ + 4096); TRRD(h1, b_ + 6144); TRRD(l2, b_ + 8192); TRRD(h2, b_ + 10240); TRRD(l3, b_ + 12288); TRRD(h3, b_ + 14336); \
        asm volatile("s_waitcnt lgkmcnt(0)" ::: "memory"); SBAR(); \
        o[d0] = __builtin_amdgcn_mfma_f32_32x32x16_bf16(pa0, (bf16x8){l0[0], l0[1], l0[2], l0[3], h0[0], h0[1], h0[2], h0[3]}, o[d0], 0, 0, 0); \
        o[d0] = __builtin_amdgcn_mfma_f32_32x32x16_bf16(pa1, (bf16x8){l1[0], l1[1], l1[2], l1[3], h1[0], h1[1], h1[2], h1[3]}, o[d0], 0, 0, 0); \
        o[d0] = __builtin_amdgcn_mfma_f32_32x32x16_bf16(pa2, (bf16x8){l2[0], l2[1], l2[2], l2[3], h2[0], h2[1], h2[2], h2[3]}, o[d0], 0, 0, 0); \
        o[d0] = __builtin_amdgcn_mfma_f32_32x32x16_bf16(pa3, (bf16x8){l3[0], l3[1], l3[2], l3[3], h3[0], h3[1], h3[2], h3[3]}, o[d0], 0, 0, 0); } while (0)
    PV_D0(0); PV_D0(1); PV_D0(2); PV_D0(3);
#undef PV_D0
#undef TRRD
}

struct BlockArgs {
    const bf16_t* Q; const bf16_t* K; const bf16_t* V;
    bf16_t* O;
    int qb;
    const float* frel; const f32x2* fbase;
    float* cst;
    const unsigned char* Q8; const unsigned char* K8;
    const unsigned char* VT;
    const float* cst2; unsigned* cmb; const float* lam;
    int map;
    int jlo0;
    float onscale; const float* onorm;
};

template <int MODE>
__device__ __forceinline__ void attn_block(LAS char* lds, const BlockArgs& B, int wave_) {
    const int MAP = (MODE == 2) ? B.map : 0;
    constexpr int ND = (MODE == 2) ? 4 : 8;
    constexpr bool SK = MODE != 0;
    const int tid = launder_tid(wave_), wid = wave_, lane = tid & 63, r32 = lane & 31, hi = lane >> 5;
    const int qb = B.qb, P0 = qb * 256;
    const int j_lo = (MODE == 1) ? (qb >= 2 ? 4 * qb - 8 : 0) : (MODE == 0) ? B.jlo0 : 0;
    const int NT = 4 * qb + 4 - j_lo;
    const int qlo = P0 + wid * 32, qm = qlo + r32 - 4 * hi, cq = 4 * qb + (wid >> 1);
    LAS char* V_lds = lds + OFF_V; LAS char* K_lds = lds + OFF_K;
    LAS float* ws = (LAS float*)(lds + OFF_WS) + wid * 64; LAS float* li_l = ws; LAS float* al_l = ws + 32;
    LAS float* ba = (LAS float*)(lds + OFF_BA); LAS float* tb = (LAS float*)(lds + OFF_TB);
    constexpr bool LS8 = MODE == 2 && MK_PV8 && MK_LS8;
    float m_reg = -1e30f, l_reg = 0; f32x16 o[LS8 ? 5 : 4]; f32x16 negm;
    { float z_ = 0.f; asm volatile("" : "+v"(z_));
#pragma unroll
      for (int r = 0; r < 16; ++r) { o[0][r] = z_; o[1][r] = z_; o[2][r] = z_; o[3][r] = z_; negm[r] = z_; if constexpr (LS8) o[4][r] = z_; } }
    i32x8 ones8; if constexpr (LS8) { int one_ = 0x38383838; asm volatile("" : "+v"(one_));
#pragma unroll
        for (int j = 0; j < 8; ++j) ones8[j] = one_; }
    const int sr = tid >> 4, sc = (tid & 15) * 8, vst0 = v_st(sr, sc), vst1 = v_st(32 + sr, sc), kws = KSWZ(sr, sc * 2);
    const int vb0 = (int)(unsigned)(uintptr_t)lds + v_rd_base(lane);
    const bf16_t* Kh = B.K; const bf16_t* Vh = B.V;
    bf16x8 st_v0, st_v1, st_k0, st_k1; float st_b = 0.f;
    constexpr bool QKAB = MODE != 2 && MK_QK8AB;
    const int kabst = (tid >> 3) * 144 + 16 * (tid & 7); LAS const char* kbab = K_lds + r32 * 144 + 32 * hi;
    constexpr bool PV8 = MODE == 2 && MK_PV8, KH = MODE == 2 && MK_KHALF, QK8 = MODE == 2 && MK_QK8;
    u32x2 st_k8; const int k8st = (tid >> 3) * 80 + 8 * (tid & 7);
    LAS const char* kb8 = K_lds + r32 * 80 + 32 * hi;
    const int kws2 = KSWZ(tid >> 3, (tid & 7) * 16) + MAP * 128, v8st = (tid >> 2) * 80 + 16 * (tid & 3);
    const bf16_t* Kh2 = Kh + (size_t)(tid >> 3) * NPROJ + 64 * MAP + (tid & 7) * 8;
    i32x8 p8; LAS const char* vb8 = V_lds + r32 * 80 + 32 * hi;
    if constexpr (MODE == 2 && MK_PV8) { int z8_ = 0; asm volatile("" : "+v"(z8_));
#pragma unroll
        for (int j = 0; j < 8; ++j) p8[j] = z8_; }
    f32x2 fbq = {0.f, 0.f}; if (MODE == 0) fbq = B.fbase[qb];
#define KBASE(t) ((j_lo + (t)) * 64)
#define ACT(t) ((MODE == 0) ? true : (MODE == 1) ? ((j_lo + (t)) + 8 >= cq && (j_lo + (t)) <= cq) : ((j_lo + (t)) <= cq))
#define ROWP(p, k0, rr) ((p) + (size_t)((k0) + (rr)) * NPROJ + sc)
#define VMW() asm volatile("s_waitcnt vmcnt(0)" ::: "memory")
#define SLOAD_H(t) do { const int k0_ = KBASE(t); if constexpr (PV8) st_v0 = *(const bf16x8*)(B.VT + (size_t)(j_lo + (t)) * 8192 + (unsigned)(tid * 16)); else { st_v0 = *(const bf16x8*)ROWP(Vh, k0_, sr); st_v1 = *(const bf16x8*)ROWP(Vh, k0_, 32 + sr); } \
        if constexpr (QK8) st_k8 = *(const u32x2*)(B.K8 + (size_t)k0_ * 64 + (unsigned)(tid * 8)); else if constexpr (KH) st_k0 = *(const bf16x8*)(Kh2 + (size_t)k0_ * NPROJ); else if constexpr (QKAB) st_k0 = *(const bf16x8*)(B.K8 + (size_t)k0_ * 128 + (unsigned)(tid * 16)); else { st_k0 = *(const bf16x8*)ROWP(Kh, k0_, sr); st_k1 = *(const bf16x8*)ROWP(Kh, k0_, 32 + sr); } if (MODE == 0 && tid < 64) st_b = B.frel[k0_ + tid]; } while (0)
#define SWRITE_HK(bf, t) do { if constexpr (QK8) *(LAS u32x2*)(K_lds + (bf) * SHM_K + k8st) = st_k8; else if constexpr (KH) *(LAS bf16x8*)(K_lds + (bf) * SHM_K + kws2) = st_k0; else if constexpr (QKAB) *(LAS bf16x8*)(K_lds + (bf) * SHM_K + kabst) = st_k0; else { *(LAS bf16x8*)(K_lds + (bf) * SHM_K + kws) = st_k0; *(LAS bf16x8*)(K_lds + (bf) * SHM_K + kws + 32 * 256) = st_k1; } \
        if (MODE == 0 && tid < 64) { const f32x2 fk_ = B.fbase[(j_lo + (t)) >> 2]; const float cst_ = (fbq.x - fk_.x) + (fbq.y - fk_.y); ba[(bf) * 64 + tid] = (cst_ - st_b) * LOG2E; } } while (0)
#define SWRITE_HV(bf) do { if constexpr (PV8) *(LAS bf16x8*)(V_lds + (bf) * SHM_V + v8st) = st_v0; else { *(LAS bf16x8*)(V_lds + (bf) * SHM_V + vst0) = st_v0; *(LAS bf16x8*)(V_lds + (bf) * SHM_V + vst1) = st_v1; } } while (0)
#define FIN(P0_, P1_, al_) do { if constexpr (LS8) finishLS8(P0_, P1_, p8); else if constexpr (PV8) finishSM8(P0_, P1_, al_, l_reg, p8); else finishSM(P0_, P1_, al_, l_reg, pa0, pa1, pa2, pa3); } while (0)
#define PVT(act_) do { if constexpr (LS8) { if (act_) { pv8(o, vb8 + bp * SHM_V, p8, true); o[4] = __builtin_amdgcn_mfma_scale_f32_32x32x64_f8f6f4(p8, ones8, o[4], 0, 0, 0, 0, 0, 0); } } else if constexpr (PV8) pv8(o, vb8 + bp * SHM_V, p8, act_); else pv_tile(o, vb0 + bp * SHM_V, pa0, pa1, pa2, pa3, act_); } while (0)
#define SWRITE_H(bf, t) do { SWRITE_HV(bf); SWRITE_HK(bf, t); } while (0)
#define RESC(a) do { if (__any((a) < 1.f)) { if (hi == 0) al_l[r32] = (a); asm volatile("s_waitcnt lgkmcnt(0)" ::: "memory"); \
        _Pragma("unroll") for (int d_ = 0; d_ < (LS8 ? 5 : 4); ++d_) _Pragma("unroll") for (int r = 0; r < 16; ++r) o[d_][r] *= al_l[crow(r, hi)]; } } while (0)
#define MASKT(P0_, P1_, t) do { if (MODE == 0) { const int kb_ = KBASE(t); if (kb_ + 63 > qlo) mask_causal(P0_, P1_, qm - kb_); } } while (0)
#define QKT(KB, PX0, PX1, t) do { const bool act_ = ACT(t); \
        if (SK && !act_) { const float NEG = -__builtin_inff(); _Pragma("unroll") for (int r = 0; r < 16; ++r) { PX0[r] = NEG; PX1[r] = NEG; } } \
        else { \
            if (MODE == 0) { _Pragma("unroll") for (int j = 0; j < 4; ++j) { const f32x4 b0_ = *(const LAS f32x4*)(ba + (KB) * 64 + 8 * j + 4 * hi), b1_ = *(const LAS f32x4*)(ba + (KB) * 64 + 32 + 8 * j + 4 * hi); \
                    _Pragma("unroll") for (int q = 0; q < 4; ++q) { PX0[4 * j + q] = b0_[q]; PX1[4 * j + q] = b1_[q]; } } } \
            else if (MODE == 1) { const int dq_ = qm - KBASE(t); _Pragma("unroll") for (int r = 0; r < 16; ++r) { const int c_ = (r & 3) + 8 * (r >> 2); \
                    int i0_ = dq_ - c_, i1_ = dq_ - c_ - 32; i0_ = i0_ < -256 ? -256 : (i0_ > 256 ? 256 : i0_); i1_ = i1_ < -256 ? -256 : (i1_ > 256 ? 256 : i1_); PX0[r] = tb[i0_ + 256]; PX1[r] = tb[i1_ + 256]; } } \
            else { } \
            LAS const char* kb_[4]; _Pragma("unroll") for (int dd = 0; dd < 4; ++dd) kb_[dd] = K_lds + (KB) * SHM_K + KSWZ(r32, (dd * 16 + hi * 8) * 2); \
            if constexpr (QKAB) { i32x8 k0a_, k0b_, k1a_, k1b_; LAS const char* a_ = kbab + (KB) * SHM_K;      \
                k0a_.lo = *(LAS const i32x4*)a_; k0a_.hi = *(LAS const i32x4*)(a_ + 16); k0b_.lo = *(LAS const i32x4*)(a_ + 64); k0b_.hi = *(LAS const i32x4*)(a_ + 80); \
                k1a_.lo = *(LAS const i32x4*)(a_ + 4608); k1a_.hi = *(LAS const i32x4*)(a_ + 4624); k1b_.lo = *(LAS const i32x4*)(a_ + 4672); k1b_.hi = *(LAS const i32x4*)(a_ + 4688); \
                PX0 = __builtin_amdgcn_mfma_scale_f32_32x32x64_f8f6f4(k0a_, q8, PX0, 0, 0, 0, 0, 0, 0); PX1 = __builtin_amdgcn_mfma_scale_f32_32x32x64_f8f6f4(k1a_, q8, PX1, 0, 0, 0, 0, 0, 0); \
                PX0 = __builtin_amdgcn_mfma_scale_f32_32x32x64_f8f6f4(k0b_, q8b, PX0, 0, 0, 0, 0, 0, 0); PX1 = __builtin_amdgcn_mfma_scale_f32_32x32x64_f8f6f4(k1b_, q8b, PX1, 0, 0, 0, 0, 0, 0); } \
            else if constexpr (QK8) { i32x8 ka_, kc_; LAS const char* a_ = kb8 + (KB) * SHM_K; ka_.lo = *(LAS const i32x4*)a_; ka_.hi = *(LAS const i32x4*)(a_ + 16); kc_.lo = *(LAS const i32x4*)(a_ + 2560); kc_.hi = *(LAS const i32x4*)(a_ + 2576); \
                PX0 = __builtin_amdgcn_mfma_scale_f32_32x32x64_f8f6f4(ka_, q8, negm, 0, 0, 0, 0, 0, 0); PX1 = __builtin_amdgcn_mfma_scale_f32_32x32x64_f8f6f4(kc_, q8, negm, 0, 0, 0, 0, 0, 0); } \
            else if constexpr (MODE == 2) { bf16x8 kf0_[4], kf1_[4];     \
                _Pragma("unroll") for (int d0 = 0; d0 < 4; ++d0) { LAS const char* a_ = kb_[d0] + MAP * 128; kf0_[d0] = *(LAS const bf16x8*)a_; kf1_[d0] = *(LAS const bf16x8*)(a_ + 32 * 256); } \
                PX0 = __builtin_amdgcn_mfma_f32_32x32x16_bf16(kf0_[0], qr[0], negm, 0, 0, 0); PX1 = __builtin_amdgcn_mfma_f32_32x32x16_bf16(kf1_[0], qr[0], negm, 0, 0, 0); \
                _Pragma("unroll") for (int d0 = 1; d0 < 4; ++d0) { PX0 = __builtin_amdgcn_mfma_f32_32x32x16_bf16(kf0_[d0], qr[d0], PX0, 0, 0, 0); PX1 = __builtin_amdgcn_mfma_f32_32x32x16_bf16(kf1_[d0], qr[d0], PX1, 0, 0, 0); } } \
            else { _Pragma("unroll") for (int d0 = 0; d0 < ND; ++d0) { LAS const char* a_ = kb_[d0 & 3] + (d0 >> 2) * 128; \
                const bf16x8 b0_ = *(LAS const bf16x8*)a_, b1_ = *(LAS const bf16x8*)(a_ + 32 * 256); \
                PX0 = __builtin_amdgcn_mfma_f32_32x32x16_bf16(b0_, qr[d0], PX0, 0, 0, 0); PX1 = __builtin_amdgcn_mfma_f32_32x32x16_bf16(b1_, qr[d0], PX1, 0, 0, 0); } } } } while (0)
    bf16x8 qr[ND]; i32x8 q8, q8b;
    if constexpr (QKAB) { const unsigned char* qp_ = B.Q8 + (size_t)(wid * 32 + r32) * 128 + 32 * hi; q8.lo = *(const i32x4*)qp_; q8.hi = *(const i32x4*)(qp_ + 16); q8b.lo = *(const i32x4*)(qp_ + 64); q8b.hi = *(const i32x4*)(qp_ + 80); }
    else if constexpr (QK8) { const unsigned char* qp_ = B.Q8 + (size_t)(wid * 32 + r32) * 64 + 32 * hi; q8.lo = *(const i32x4*)qp_; q8.hi = *(const i32x4*)(qp_ + 16); }
    else
#pragma unroll
    for (int d0 = 0; d0 < ND; ++d0) qr[d0] = *(const bf16x8*)(B.Q + (size_t)(wid * 32 + r32) * NPROJ + ((MODE == 2) ? 64 * MAP : 0) + d0 * 16 + hi * 8);
    SLOAD_H(0); VMW(); SWRITE_H(0, 0);
    if (NT > 1) SLOAD_H(1);
    __syncthreads();
    f32x16 pA0, pA1, pB0, pB1; float mnA, mnB, alA, alB; bf16x8 pa0, pa1, pa2, pa3;
    SBAR(); QKT(0, pA0, pA1, 0);
    MASKT(pA0, pA1, 0); if constexpr (LS8) { partialSM_first8(pA0, pA1, m_reg); alA = 1.f; } else partialSM(pA0, pA1, m_reg, mnA, alA);
    if constexpr (MODE == 2) {
#pragma unroll
        for (int r = 0; r < 16; ++r) negm[r] = -m_reg;
        asm volatile("" : "+v"(negm)); }
    if (NT > 1) { VMW(); SWRITE_H(1, 1); }
    __syncthreads();
    int bp = 0, bc = 1, bn = 2;
#define STEP(PX0, PX1, mnX, alX, PY0, PY1, alY, t) do { \
        if ((t) + 1 < NT) { SLOAD_H((t) + 1); } \
        SBAR(); QKT(bc, PX0, PX1, t); \
        FIN(PY0, PY1, alY); SBAR(); \
        PVT(!SK || ACT((t) - 1)); MASKT(PX0, PX1, (t)); if constexpr (LS8) partialSM_rel8(PX0, PX1, m_reg, alX, negm); else if constexpr (MODE == 2) partialSM_rel(PX0, PX1, m_reg, alX, negm); else partialSM(PX0, PX1, m_reg, mnX, alX); \
        RESC(alX); \
        if ((t) + 1 < NT) { VMW(); SWRITE_H(bn, (t) + 1); } \
        __syncthreads(); \
        bp = bc; bc = bn; bn = (bn == NBUF - 1) ? 0 : bn + 1; } while (0)
#define MF8(a_, b_, c_) __builtin_amdgcn_mfma_scale_f32_32x32x64_f8f6f4(a_, b_, c_, 0, 0, 0, 0, 0, 0)
#define LD8(dst_, adr_) do { dst_.lo = *(LAS const i32x4*)(adr_); dst_.hi = *(LAS const i32x4*)((adr_) + 16); } while (0)
#define EXPR(P_, b_) _Pragma("unroll") for (int r_ = (b_); r_ < (b_) + 8; ++r_) P_[r_] = __builtin_amdgcn_exp2f(P_[r_])
#define STEPF(PX0, PX1, alX, PY0, PY1, t) do { \
        SLOAD_H((t) + 1); \
        i32x8 ka_, kc_, vx_, vy_; LAS const char* ak_ = kb8 + bc * SHM_K; LAS const char* av_ = vb8 + bp * SHM_V; \
        LD8(ka_, ak_); LD8(kc_, ak_ + 2560); LD8(vx_, av_); LD8(vy_, av_ + 2560); \
        EXPR(PY1, 0); SBAR(); \
        PX0 = MF8(ka_, q8, negm); EXPR(PY1, 8); SBAR(); \
        PX1 = MF8(kc_, q8, negm); cvt16(PY0, PY1, p8); SBAR(); \
        o[0] = MF8(p8, vx_, o[0]); LD8(vx_, av_ + 5120); float pm_ = max16(PX0); SBAR(); \
        o[1] = MF8(p8, vy_, o[1]); LD8(vy_, av_ + 7680); pm_ = fmaxf(pm_, max16(PX1)); \
        { auto rr_ = __builtin_amdgcn_permlane32_swap(__float_as_uint(pm_), __float_as_uint(pm_), false, false); pm_ = fmaxf(__uint_as_float(rr_[0]), __uint_as_float(rr_[1])); } SBAR(); \
        o[4] = MF8(p8, onesF, o[4]); EXPR(PX0, 0); SBAR(); \
        o[2] = MF8(p8, vx_, o[2]); EXPR(PX0, 8); SBAR(); \
        o[3] = MF8(p8, vy_, o[3]); VMW(); SWRITE_H(bn, (t) + 1); SBAR(); \
        alX = 1.f; \
        if (__builtin_expect(!__all(pm_ <= 8.f), 0)) { const float d_ = pm_ > 8.f ? pm_ - PSH : 0.f; m_reg += d_; alX = __builtin_amdgcn_exp2f(-d_); \
            _Pragma("unroll") for (int r = 0; r < 16; ++r) negm[r] = -m_reg; \
            asm volatile("" : "+v"(negm)); \
              \
            LD8(ka_, ak_); LD8(kc_, ak_ + 2560); PX0 = MF8(ka_, q8, negm); PX1 = MF8(kc_, q8, negm); EXPR(PX0, 0); EXPR(PX0, 8); } \
        RESC(alX); \
        __syncthreads(); \
        bp = bc; bc = bn; bn = (bn == NBUF - 1) ? 0 : bn + 1; } while (0)
    int t = 1;
    if constexpr (LS8 && QK8 && MK_STEPF) {
        i32x8 onesF; { int one_; asm volatile("v_mov_b32 %0, 0x38383838" : "=v"(one_));
#pragma unroll
            for (int j = 0; j < 8; ++j) onesF[j] = one_; }
        for (; t + 1 <= 4 * qb; t += 2) { STEPF(pB0, pB1, alB, pA0, pA1, t); STEPF(pA0, pA1, alA, pB0, pB1, t + 1); }
    }
    for (; t + 1 < NT; t += 2) {
        STEP(pB0, pB1, mnB, alB, pA0, pA1, alA, t);
        STEP(pA0, pA1, mnA, alA, pB0, pB1, alB, t + 1);
    }
    if (t < NT) {
        STEP(pB0, pB1, mnB, alB, pA0, pA1, alA, t);
        FIN(pB0, pB1, alB); SBAR();
    } else {
        FIN(pA0, pA1, alA); SBAR();
    }
    PVT(!SK || ACT(NT - 1));
    SBAR();
    if (!LS8) { if (hi == 0) li_l[r32] = l_reg; asm volatile("s_waitcnt lgkmcnt(0)" ::: "memory"); }
    float rli[16];
#pragma unroll
    for (int r = 0; r < 16; ++r) { if constexpr (LS8) rli[r] = __builtin_amdgcn_rcpf(o[4][r]) * (1.0f / SV8); else rli[r] = __builtin_amdgcn_rcpf(li_l[crow(r, hi)]) * (PV8 ? 1.0f / (SP8 * SV8) : 1.0f); }
#pragma unroll
    for (int d0 = 0; d0 < 4; ++d0)
#pragma unroll
        for (int r = 0; r < 16; ++r) o[d0][r] *= rli[r];
    bool fin = MODE != 2;
    if constexpr (MODE == 2) {
        float* cs = B.cst + wid * 4096 + lane;
#pragma unroll
        for (int r = 0; r < 16; ++r)
#pragma unroll
            for (int d0 = 0; d0 < 4; ++d0) cs[(r * 4 + d0) * 64] = o[d0][r];
        if constexpr (MK_CMB) {
            LAS unsigned* flag = (LAS unsigned*)(lds + OFF_WS);
            asm volatile("s_waitcnt vmcnt(0)" ::: "memory"); __syncthreads();
            if (wid == 0 && lane_now() == 0) { __builtin_amdgcn_fence(__ATOMIC_RELEASE, "agent"); asm volatile("s_waitcnt vmcnt(0)" ::: "memory");
                const unsigned old_ = __hip_atomic_fetch_add(B.cmb, 1u, __ATOMIC_RELAXED, __HIP_MEMORY_SCOPE_AGENT);
                if (old_ & 1u) { __builtin_amdgcn_fence(__ATOMIC_ACQUIRE, "agent"); asm volatile("s_waitcnt vmcnt(0)" ::: "memory"); }
                flag[0] = old_; }
            __syncthreads();
            fin = (__builtin_amdgcn_readfirstlane(flag[0]) & 1u) != 0;
            if (fin) {
                const float* lm = B.lam; const int ln = lane_now();
                float sa = lm[ln] * lm[64 + ln], sb = lm[128 + ln] * lm[192 + ln];
                sa += sxor<1>(sa); sa += sxor<2>(sa); sa += sxor<4>(sa); sa += sxor<8>(sa); sa += sxor<16>(sa); sb += sxor<1>(sb); sb += sxor<2>(sb); sb += sxor<4>(sb); sb += sxor<8>(sb); sb += sxor<16>(sb);
                { auto ra_ = __builtin_amdgcn_permlane32_swap(__float_as_uint(sa), __float_as_uint(sa), false, false); sa = __uint_as_float(ra_[0]) + __uint_as_float(ra_[1]);
                  auto rb_ = __builtin_amdgcn_permlane32_swap(__float_as_uint(sb), __float_as_uint(sb), false, false); sb = __uint_as_float(rb_[0]) + __uint_as_float(rb_[1]); }
                const float lamf = expf(sa) - expf(sb) + (1.0f - B.onscale);
                const bool m0_ = MAP == 0;
                const float* co = B.cst2 + wid * 4096 + lane;
#pragma unroll
                for (int r = 0; r < 16; ++r)
#pragma unroll
                    for (int d0 = 0; d0 < 4; ++d0) { const float own_ = o[d0][r], oth_ = co[(r * 4 + d0) * 64]; const float a_ = m0_ ? own_ : oth_, b_ = m0_ ? oth_ : own_; o[d0][r] = a_ - b_ * lamf; }
            }
        }
    }
    if (fin) {
        float on[4];
#pragma unroll
        for (int d0 = 0; d0 < 4; ++d0) on[d0] = B.onorm[d0 * 32 + r32] * B.onscale;
        bf16_t* Ow = B.O + (size_t)(wid * 32) * D;
#pragma unroll
        for (int r = 0; r < 16; ++r) {
            float ss = (o[0][r] * o[0][r] + o[1][r] * o[1][r]) + (o[2][r] * o[2][r] + o[3][r] * o[3][r]);
            ss += sxor<1>(ss); ss += sxor<2>(ss); ss += sxor<4>(ss); ss += sxor<8>(ss); ss += sxor<16>(ss);
            const float rs = rsqrtf(ss * (1.0f / HD) + EPS); const int orow = crow(r, hi);
#pragma unroll
            for (int d0 = 0; d0 < 4; ++d0) { const float v = o[d0][r] * rs * on[d0]; const float vn = sxor<1>(v);
                if ((r32 & 1) == 0) *(unsigned*)(Ow + (size_t)orow * D + d0 * 32 + r32) = cvtpk(v, vn); } }
    }
    __syncthreads();
#undef KBASE
#undef ACT
#undef ROWP
#undef VMW
#undef SLOAD_H
#undef SWRITE_HK
#undef SWRITE_HV
#undef STEPF
#undef MF8
#undef LD8
#undef EXPR
#undef FIN
#undef PVT
#undef SWRITE_H
#undef RESC
#undef MASKT
#undef QKT
#undef STEP
}
#undef KSWZ
#undef SBAR
}

constexpr int CW_PRE = 3072;
constexpr int CW_AQ = 2048;
constexpr int N_PRE = 70, N_ATT_ITEMS = 1280 + N_PRE + (MK_XCONV ? NCV : 0);
constexpr float TAU2 = 60.f;
__device__ __forceinline__ void prepass_item(Frame& F, int k) {
    const int lane = launder_tid(F.wave) & 63, i = lane & 15, g = lane >> 4;
    const bf16_t* P = wsp<bf16_t>(F, WS_PROJ);
    for (int it = k * 24 + F.wave * 3; it < k * 24 + F.wave * 3 + 3; ++it) { const int h = it >> 8, tl = it & 255; float qm = 0.f, km = 0.f;
#pragma unroll 4
        for (int rr = 0; rr < 16; ++rr) { const size_t row = (size_t)(tl * 64 + rr * 4 + g) * NPROJ; float qf[8], kf[8]; ld8(P + row + QA + h * HD + 8 * i, qf); ld8(P + row + KA + h * HD + 8 * i, kf);
            float sq = 0.f, sk = 0.f;
#pragma unroll
            for (int j = 0; j < 8; ++j) { sq += qf[j] * qf[j]; sk += kf[j] * kf[j]; }
            sq += sxor<1>(sq); sq += sxor<2>(sq); sq += sxor<4>(sq); sq += sxor<8>(sq);
            sk += sxor<1>(sk); sk += sxor<2>(sk); sk += sxor<4>(sk); sk += sxor<8>(sk);
            qm = fmaxf(qm, sq); km = fmaxf(km, sk); }
        qm = half_max(fmaxf(qm, sxor<16>(qm))); km = half_max(fmaxf(km, sxor<16>(km)));
        if (lane == 0) { wsp<float>(F, WS_QN)[it] = sqrtf(qm) * (MK_QK8AB ? 1.08f : 1.001f); wsp<float>(F, WS_KN)[it] = sqrtf(km) * (MK_QK8AB ? 1.08f : 1.001f); } }
}
__device__ __forceinline__ void attn_phase(Frame& F, int l, unsigned* ctl, volatile LAS unsigned* MISC) {
    const float laminit = 0.8f - 0.6f * expf(-0.3f * (float)l);
    const bf16_t* P = wsp<bf16_t>(F, WS_PROJ); bf16_t* Ob = wsp<bf16_t>(F, WS_O);
    LAS char* lds = (LAS char*)F.lds; bool pre_ok = false;
    for (;;) {
        { unsigned* qh_ = ctl + CW_AQ + 64 * l; asm volatile("" : "+s"(qh_));
          if (launder_tid(F.wave) == 0) MISC[16] = __hip_atomic_fetch_add(qh_, 1u, __ATOMIC_RELAXED, __HIP_MEMORY_SCOPE_AGENT); }
        __syncthreads();
        int it = (int)__builtin_amdgcn_readfirstlane(MISC[16]);
        __syncthreads();
        if (it >= ((MK_DUP & 8) ? 2 : 1) * N_ATT_ITEMS) break;
        if (it >= N_ATT_ITEMS) it -= N_ATT_ITEMS;
#if MK_XCONV
        if (it >= 256) {
            if (it < 512 + NCV) { const int p = it - 256, g = p / 9, j = p - 9 * g;
                if (j == 0) it = 256 + 2 * g; else if (j == 4) it = 257 + 2 * g;
                else { expert_conv_item(F, l * NCV + 7 * g + (j < 4 ? j - 1 : j - 2)); continue; } }
            else it -= NCV; }
#endif
        fa::BlockArgs B; B.onscale = 1.f; B.frel = nullptr; B.fbase = nullptr; B.cst = nullptr; B.jlo0 = 0; B.map = 0; B.cst2 = nullptr; B.cmb = nullptr; B.lam = nullptr; B.VT = nullptr; B.Q8 = nullptr; B.K8 = nullptr; B.onorm = nullptr; B.O = nullptr;
        if (it < 512) { const int qb = 63 - (it >> 3), h = it & 3, mp = (it >> 2) & 1; B.qb = qb;
            B.Q = P + (size_t)qb * 256 * NPROJ + QC + h * HD; B.K = P + KC + h * HD; B.V = P + VC + h * HD; B.VT = wsp<unsigned char>(F, WS_VT8) + (size_t)h * 256 * 128 * 64;
            B.Q8 = wsp<unsigned char>(F, WS_Q8) + ((size_t)(h * 2 + mp) * S + qb * 256) * 64; B.K8 = wsp<unsigned char>(F, WS_K8) + (size_t)(h * 2 + mp) * S * 64;
            B.cst = wsp<float>(F, WS_CST) + (size_t)((mp * 4 + h) * 64 + qb) * 32768; B.cst2 = wsp<float>(F, WS_CST) + (size_t)(((mp ^ 1) * 4 + h) * 64 + qb) * 32768;
            B.cmb = ctl + CW_CMB + 256 * l + 4 * qb + h; B.lam = FIN_lam(F) + l * 4 * 64; B.onscale = 1.0f - laminit; B.onorm = FIN_onorm(F) + (l * 3 + 2) * HD; B.O = Ob + (size_t)qb * 256 * D + 1536 + h * HD;
            B.map = mp; fa::attn_block<2>(lds, B, F.wave); }
        else if (it < 512 + N_PRE) { const int k = it - 512;
            if (k < 6) scan_head(F, k); else prepass_item(F, k - 6);
            asm volatile("s_waitcnt vmcnt(0)" ::: "memory"); __syncthreads();
            if (F.wave == 0 && lane_now() == 0) { __builtin_amdgcn_fence(__ATOMIC_RELEASE, "agent"); asm volatile("s_waitcnt vmcnt(0)" ::: "memory");
                __hip_atomic_fetch_add(ctl + CW_PRE + 64 * l, 1u, __ATOMIC_RELAXED, __HIP_MEMORY_SCOPE_AGENT); } }
        else if (it < 896 + N_PRE) { const int j = it - 512 - N_PRE, h = j % 6, qb = 63 - j / 6; B.qb = qb;
            B.Q = P + (size_t)qb * 256 * NPROJ + QB_ + h * HD; B.K = P + KB_ + h * HD; B.V = P + VB_ + h * HD; B.O = Ob + (size_t)qb * 256 * D + 768 + h * HD; B.onorm = FIN_onorm(F) + (l * 3 + 1) * HD;
            B.Q8 = wsp<unsigned char>(F, WS_Q8AB) + ((size_t)(6 + h) * S + qb * 256) * 128; B.K8 = wsp<unsigned char>(F, WS_K8AB) + (size_t)(6 + h) * S * 128;
            LAS float* tb = (LAS float*)(lds + fa::OFF_TB); const float* rb = FIN_rel_bias(F) + (size_t)(l * NHB + h) * 513;
            for (int i = launder_tid(F.wave); i < 513; i += 512) tb[i] = rb[i] * LOG2E;
            fa::attn_block<1>(lds, B, F.wave); }
        else { const int j = it - 896 - N_PRE, h = j % 6, qb = 63 - j / 6; B.qb = qb;
            B.Q = P + (size_t)qb * 256 * NPROJ + QA + h * HD; B.K = P + KA + h * HD; B.V = P + VA + h * HD; B.O = Ob + (size_t)qb * 256 * D + h * HD;
            B.Q8 = wsp<unsigned char>(F, WS_Q8AB) + ((size_t)h * S + qb * 256) * 128; B.K8 = wsp<unsigned char>(F, WS_K8AB) + (size_t)h * S * 128;
            B.frel = wsp<float>(F, WS_FREL) + (size_t)h * S; B.fbase = wsp<f32x2>(F, WS_FBASE) + h * 64; B.onorm = FIN_onorm(F) + (l * 3 + 0) * HD;
            if (!pre_ok) {
                if (F.wave == 0 && lane_now() == 0) { unsigned* pc_ = ctl + CW_PRE + 64 * l; unsigned sp_ = 0;
                    while (__hip_atomic_load(pc_, __ATOMIC_RELAXED, __HIP_MEMORY_SCOPE_AGENT) < (unsigned)N_PRE) { __builtin_amdgcn_s_sleep(2); if (++sp_ > (1u << 22)) { __hip_atomic_store(ctl + CW_TMO, 1u, __ATOMIC_RELAXED, __HIP_MEMORY_SCOPE_AGENT); break; } }
                    __builtin_amdgcn_fence(__ATOMIC_ACQUIRE, "agent"); asm volatile("s_waitcnt vmcnt(0)" ::: "memory"); }
                __syncthreads(); pre_ok = true; }
            const float* qn = wsp<float>(F, WS_QN) + h * 256; const float* kn = wsp<float>(F, WS_KN) + h * 256;
            const int lane = launder_tid(F.wave) & 63;
            float kmax = fmaxf(fmaxf(kn[lane], kn[64 + lane]), fmaxf(kn[128 + lane], kn[192 + lane]));
            kmax = wave_max(kmax);
            const float qmax = fmaxf(fmaxf(qn[4 * qb], qn[4 * qb + 1]), fmaxf(qn[4 * qb + 2], qn[4 * qb + 3]));
            const float nb = qmax * 2.f * kmax; const f32x2 fq = B.fbase[qb];
            int jl = 4 * qb;
#pragma unroll
            for (int c = 3; c >= 0; --c) { const int J = 64 * c + lane; bool keep = false;
                if (J < 4 * qb) { const f32x2 fk = B.fbase[J >> 2]; const float dF = (((fq.x - fk.x) + (fq.y - fk.y)) - B.frel[64 * J + 63]) * LOG2E; keep = !(nb + dF < -TAU2); }
                const unsigned long long mk = __ballot(keep); if (mk) jl = 64 * c + (int)__builtin_ctzll(mk); }
            B.jlo0 = __builtin_amdgcn_readfirstlane(jl);
            fa::attn_block<0>(lds, B, F.wave); }
    }
}
__device__ __forceinline__ void attn_combine(Frame& F, int l) {
    const int gw = F.vcu * 8 + F.wave, NGW = F.G * 8, lane = F.lane;
    const float laminit = 0.8f - 0.6f * expf(-0.3f * (float)l);
    const float* lm = FIN_lam(F) + l * 4 * 64;
    const float sa = wave_sum(lm[lane] * lm[64 + lane]), sb = wave_sum(lm[128 + lane] * lm[192 + lane]);
    const float lamf = expf(sa) - expf(sb) + laminit;
    const float* on = FIN_onorm(F) + (l * 3 + 2) * HD + 8 * (lane & 15);
    float g8[8];
#pragma unroll
    for (int j = 0; j < 8; ++j) g8[j] = on[j] * (1.0f - laminit);
    const float* c0 = wsp<float>(F, WS_CST); const float* c1 = c0 + (size_t)4 * 64 * 32768; bf16_t* Ob = wsp<bf16_t>(F, WS_O);
    const int hh = lane >> 4, i16 = lane & 15;
    for (int t = gw; t < S; t += NGW) {
        const int qb = t >> 8, wv = (t >> 5) & 7, row32 = t & 31, hi = (row32 >> 2) & 1, r = (row32 & 3) + 4 * (row32 >> 3);
        const size_t off = (size_t)(hh * 64 + qb) * 32768 + wv * 4096 + (r * 4 + (i16 >> 2)) * 64 + 32 * hi + 8 * (i16 & 3);
        const f32x4 a0 = *(const f32x4*)(c0 + off), a1 = *(const f32x4*)(c0 + off + 4);
        const f32x4 b0 = *(const f32x4*)(c1 + off), b1 = *(const f32x4*)(c1 + off + 4);
        const f32x4 r0 = a0 - b0 * lamf, r1 = a1 - b1 * lamf;
        float ss = (r0.x * r0.x + r0.y * r0.y) + (r0.z * r0.z + r0.w * r0.w) + (r1.x * r1.x + r1.y * r1.y) + (r1.z * r1.z + r1.w * r1.w);
        ss += sxor<1>(ss); ss += sxor<2>(ss); ss += sxor<4>(ss); ss += sxor<8>(ss);
        const float rs = rsqrtf(ss * (1.0f / HD) + EPS);
        u32x4 w; w.x = cvt_pk_bf16(r0.x * rs * g8[0], r0.y * rs * g8[1]); w.y = cvt_pk_bf16(r0.z * rs * g8[2], r0.w * rs * g8[3]);
        w.z = cvt_pk_bf16(r1.x * rs * g8[4], r1.y * rs * g8[5]); w.w = cvt_pk_bf16(r1.z * rs * g8[6], r1.w * rs * g8[7]);
        *(u32x4*)(Ob + (size_t)t * D + 1536 + 8 * lane) = w; }
}

__device__ __forceinline__ void sort_phase(Frame& F) {
    LAS int* cnt = (LAS int*)F.lds; LAS int* pre = cnt + 2048; LAS int* tot = pre + 2048; LAS int* base = tot + 8; LAS int* sl = base + 16;
    const unsigned* toke = wsp<unsigned>(F, WS_TOKE);
    const int lane = F.lane, wave = F.wave, tid = F.tid;
    for (int c = wave; c < 256; c += 8) { const unsigned pe = toke[c * 64 + lane]; const int e1 = pe & 0xff, e2 = pe >> 8;
#pragma unroll
        for (int e = 0; e < 8; ++e) { const unsigned long long mk = __ballot(e1 == e || e2 == e); if (lane == 0) cnt[c * 8 + e] = __popcll(mk); } }
    __syncthreads();
    if (tid < 8) { int run = 0; for (int c = 0; c < 256; ++c) { pre[c * 8 + tid] = run; run += cnt[c * 8 + tid]; } tot[tid] = run; }
    __syncthreads();
    if (tid == 0) { int b = 0; for (int e = 0; e < 8; ++e) { base[e] = b; b += (tot[e] + 255) & ~255; } base[8] = b; }
    __syncthreads();
    if (blockIdx.x == 0) { int* tl = wsp<int>(F, WS_TILES) + 256; const int ntl = base[8] >> 8;
        if (tid == 0) tl[0] = ntl;
        if (tid < MAXTILES && tid < ntl) { int e = 0; while (e < 7 && tid * 256 >= base[e + 1]) ++e; tl[1 + tid] = e; } }
    const bf16_t* H = wsp<bf16_t>(F, WS_H); unsigned char* HS = wsp<unsigned char>(F, WS_HS); int* toks = wsp<int>(F, WS_TOKS);
    for (int c = blockIdx.x; c < 256; c += F.G) {
        if (wave == 0) { const int tok = c * 64 + lane; const unsigned pe = toke[tok]; const int e1 = pe & 0xff, e2 = pe >> 8; int s1 = 0, s2 = 0;
            const unsigned long long lt = (1ull << lane) - 1ull;
#pragma unroll
            for (int e = 0; e < 8; ++e) { const unsigned long long mk = __ballot(e1 == e || e2 == e); const int slot = base[e] + pre[c * 8 + e] + __popcll(mk & lt); if (e1 == e) s1 = slot; if (e2 == e) s2 = slot; }
            toks[2 * tok] = s1; toks[2 * tok + 1] = s2; sl[2 * lane] = s1; sl[2 * lane + 1] = s2; }
        __syncthreads();
        for (int p = wave * 16; p < wave * 16 + 16; ++p) { const int tok = c * 64 + (p >> 1), slot = sl[p];
            const u32x4* src = (const u32x4*)(H + (size_t)tok * D); u32x4* dst = (u32x4*)(HS + (size_t)slot * D);
#pragma unroll
            for (int q = 0; q < 2; ++q) { const u32x4 a = src[2 * (lane + 64 * q)], b = src[2 * (lane + 64 * q) + 1]; u32x4 o;
                o.x = pk4_fp8(bf_lo(a.x) * SH8, bf_hi(a.x) * SH8, bf_lo(a.y) * SH8, bf_hi(a.y) * SH8); o.y = pk4_fp8(bf_lo(a.z) * SH8, bf_hi(a.z) * SH8, bf_lo(a.w) * SH8, bf_hi(a.w) * SH8);
                o.z = pk4_fp8(bf_lo(b.x) * SH8, bf_hi(b.x) * SH8, bf_lo(b.y) * SH8, bf_hi(b.y) * SH8); o.w = pk4_fp8(bf_lo(b.z) * SH8, bf_hi(b.z) * SH8, bf_lo(b.w) * SH8, bf_hi(b.w) * SH8);
                dst[lane + 64 * q] = o; } }
        __syncthreads();
    }
}

struct Args { const void* in[20]; float* out; unsigned char* ws; int ph_lo, ph_hi; };
constexpr int NPHASE = 18;
__global__ void __launch_bounds__(512, 2) fwd(Args args) {
    extern __shared__ __attribute__((aligned(16))) unsigned char lds[];
    Frame F;
    F.lds = (LAS unsigned char*)lds;
    F.tid = threadIdx.x; F.lane = F.tid & 63; F.wave = __builtin_amdgcn_readfirstlane(F.tid >> 6); { int w_ = F.wave; asm volatile("" : "+s"(w_)); F.wave = w_; }
    F.G = gridDim.x; { const int bx = blockIdx.x; F.vcu = (F.G % 8 == 0) ? (bx % 8) * (F.G / 8) + bx / 8 : bx; }
    F.ka = (const void* const*)&args; F.ws = args.ws; F.out = args.out;
    volatile LAS unsigned* MISC = (volatile LAS unsigned*)(F.lds + MISC_OFF);
    for (int u = F.tid; u < (LDS_BYTES - MISC_OFF) / 4; u += 512) MISC[u] = 0u;
    __syncthreads();
    unsigned* ctl = (unsigned*)(F.ws + WS_CTL);
    XcdBarrier bar; bar.bar = ctl + CW_BAR; bar.x = 0; bar.st = nullptr;
    if (!MK_PER_PHASE) bar = xcd_barrier_post(ctl + CW_BAR, MISC + 8);
    const int lo = MK_PER_PHASE ? args.ph_lo : 0, hi = MK_PER_PHASE ? args.ph_hi : NPHASE;
#define IN(k) (lo <= (k) && (k) < hi)
#define SEAM(k) do { if (IN(k) && IN((k) + 1)) xcd_barrier(bar, F.wave, (unsigned*)((unsigned char*)F.ka[opq(21)] + WS_CTL) + CW_BAR); } while (0)

    if (IN(0)) { frame_tid(F); p0_prologue(F); if (MK_DUP & 1) { __syncthreads(); p0_prologue(F); } } SEAM(0);
    for (int l = 0; l < 2; ++l) {
        const int pb = 1 + 8 * l;
        if (IN(pb + 0)) { frame_tid(F); if (MK_DUP & 2) { if (l == 0) row_phase<0>(F, 0, true); else row_phase<1>(F, 1, true); } if (l == 0) row_phase<0>(F, 0); else row_phase<1>(F, 1); } SEAM(pb + 0);
        if (IN(pb + 1)) { frame_tid(F);
            pg8::Gemm g{wsp<bf16_t>(F, WS_H), wsp<bf16_t>(F, WS_WIN) + (size_t)l * NPROJ * D, 0}; typedef pg8::StaticOrder<NPROJ / 256, S / 256> SO; SO So; So.init(0, F.G, (int)blockIdx.x, nullptr);
            pg8::EpiProj E{wsp<bf16_t>(F, WS_PROJ), wsp<float>(F, WS_ROPE), wsp<unsigned char>(F, WS_Q8), wsp<unsigned char>(F, WS_K8), wsp<unsigned char>(F, WS_Q8AB), wsp<unsigned char>(F, WS_K8AB), wsp<unsigned char>(F, WS_VT8)};
            pg8::gemm_phase<D, pg8::EpiProj, SO>(F.lds, g, So, E, F.wave); if (MK_DUP & 4) pg8::gemm_phase<D, pg8::EpiProj, SO>(F.lds, g, So, E, F.wave); } SEAM(pb + 1);
        if (IN(pb + 2)) { frame_tid(F);
#if MK_NAIVE_ATTN
            naive_attn_phase(F, l);
#else
            frame_tid(F); attn_phase(F, l, (unsigned*)(F.ws + WS_CTL), MISC);
            if (!MK_CMB) { if (!MK_PER_PHASE) xcd_barrier(bar, F.wave, (unsigned*)((unsigned char*)F.ka[opq(21)] + WS_CTL) + CW_BAR);
            frame_tid(F); attn_combine(F, l); if (MK_DUP & 128) attn_combine(F, l); }
#endif
        } SEAM(pb + 2);
        if (IN(pb + 3)) { frame_tid(F); pg8::Gemm g{wsp<bf16_t>(F, WS_O), wsp<bf16_t>(F, WS_WO) + (size_t)l * D * D, 0}; typedef pg8::StaticOrder<D / 256, S / 256> SO; SO So; So.init(0, F.G, (int)blockIdx.x, nullptr);
            pg8::EpiPlain E{wsp<bf16_t>(F, WS_Y), D, 1.f};
            pg8::gemm_phase<D, pg8::EpiPlain, SO>(F.lds, g, So, E, F.wave); if (MK_DUP & 16) pg8::gemm_phase<D, pg8::EpiPlain, SO>(F.lds, g, So, E, F.wave); } SEAM(pb + 3);
        if (IN(pb + 4)) { frame_tid(F); if (MK_DUP & 2) { if (l == 0) row_phase<2>(F, 0, true); else row_phase<3>(F, 1, true); } if (l == 0) row_phase<2>(F, 0); else row_phase<3>(F, 1); } SEAM(pb + 4);
        if (IN(pb + 5)) { frame_tid(F); if (l == 1) { sort_phase(F); if (MK_DUP & 128) sort_phase(F); } } if (l == 1) SEAM(pb + 5);
        if (IN(pb + 6)) { frame_tid(F);
            if (l == 0) { typedef pg8::StaticOrder<2 * DFF / 256, S / 256> SO; SO So; So.init(0, F.G, (int)blockIdx.x, nullptr);
                pg8::Gemm g{wsp<bf16_t>(F, WS_H), wsp<bf16_t>(F, WS_WGU), 0};
#if MK_DENSE_FP8
                pg8::EpiSwiGLU8 E{wsp<unsigned char>(F, WS_ACT), DFF};
                pg8::gemm_phase<D / 2, pg8::EpiSwiGLU8, SO, true, MK_ALIGN8>(F.lds, g, So, E, F.wave); if (MK_DUP & 32) pg8::gemm_phase<D / 2, pg8::EpiSwiGLU8, SO, true, MK_ALIGN8>(F.lds, g, So, E, F.wave);
#elif MK_DENSE_DN8
                pg8::EpiSwiGLU8b E{wsp<unsigned char>(F, WS_ACT), DFF};
                pg8::gemm_phase<D, pg8::EpiSwiGLU8b, SO, false, false>(F.lds, g, So, E, F.wave);
#else
                pg8::EpiSwiGLU E{wsp<bf16_t>(F, WS_ACT), DFF};
                pg8::gemm_phase<D, pg8::EpiSwiGLU, SO>(F.lds, g, So, E, F.wave); if (MK_DUP & 32) pg8::gemm_phase<D, pg8::EpiSwiGLU, SO>(F.lds, g, So, E, F.wave);
#endif
            }
            else { typedef pg8::StaticOrder<2 * DFF / 256, 0> SO; SO So; So.init(__builtin_amdgcn_readfirstlane((wsp<int>(F, WS_TILES) + 256)[0]), F.G, (int)blockIdx.x, wsp<int>(F, WS_TILES) + 257);
                pg8::Gemm g{wsp<bf16_t>(F, WS_HS), wsp<bf16_t>(F, WS_EGU), (size_t)2 * DFF * D};
                pg8::EpiSwiGLU8 E{wsp<unsigned char>(F, WS_ACTS), DFF};
                pg8::gemm_phase<D / 2, pg8::EpiSwiGLU8, SO, true, MK_ALIGN8>(F.lds, g, So, E, F.wave); if (MK_DUP & 32) pg8::gemm_phase<D / 2, pg8::EpiSwiGLU8, SO, true, MK_ALIGN8>(F.lds, g, So, E, F.wave); } } SEAM(pb + 6);
        if (IN(pb + 7)) { frame_tid(F);
            if (l == 0) { typedef pg8::StaticOrder<D / 256, S / 256> SO; SO So; So.init(0, F.G, (int)blockIdx.x, nullptr);
                pg8::Gemm g{wsp<bf16_t>(F, WS_ACT), wsp<bf16_t>(F, WS_WD), 0};
#if MK_DENSE_FP8 || MK_DENSE_DN8
                pg8::EpiPlain E{wsp<bf16_t>(F, WS_Y), D, 1.0f / (SA8 * SWD8)};
                pg8::gemm_phase<DFF / 2, pg8::EpiPlain, SO, true, MK_ALIGN8>(F.lds, g, So, E, F.wave); if (MK_DUP & 64) pg8::gemm_phase<DFF / 2, pg8::EpiPlain, SO, true, MK_ALIGN8>(F.lds, g, So, E, F.wave);
#else
                pg8::EpiPlain E{wsp<bf16_t>(F, WS_Y), D, 1.f};
                pg8::gemm_phase<DFF, pg8::EpiPlain, SO>(F.lds, g, So, E, F.wave); if (MK_DUP & 64) pg8::gemm_phase<DFF, pg8::EpiPlain, SO>(F.lds, g, So, E, F.wave);
#endif
            }
            else { const int ntl = __builtin_amdgcn_readfirstlane((wsp<int>(F, WS_TILES) + 256)[0]);
                pg8::Gemm g{wsp<bf16_t>(F, WS_ACTS), wsp<bf16_t>(F, WS_ED), (size_t)DFF * D};
                if (F.G == 256 && ntl >= 128 && ntl < 160) {
                    { typedef pg8::StaticOrder<D / 256, 128> SO; SO So; So.init(0, F.G, (int)blockIdx.x, wsp<int>(F, WS_TILES) + 257);
                      pg8::EpiPlain E{wsp<bf16_t>(F, WS_YP), D, 1.0f / (SA8 * SWD8)};
                      pg8::gemm_phase<DFF / 2, pg8::EpiPlain, SO, true, MK_ALIGN8>(F.lds, g, So, E, F.wave); if (MK_DUP & 64) pg8::gemm_phase<DFF / 2, pg8::EpiPlain, SO, true, MK_ALIGN8>(F.lds, g, So, E, F.wave); }
                    { pg8::SplitOrder So; So.init(ntl - 128, (int)blockIdx.x, wsp<int>(F, WS_TILES) + 257);
                      pg8::EpiPartial E{wsp<float>(F, WS_YPS), D};
                      pg8::gemm_phase<DFF / 2, pg8::EpiPartial, pg8::SplitOrder, true, MK_ALIGN8, 14>(F.lds, g, So, E, F.wave); } }
                else { typedef pg8::StaticOrder<D / 256, 0> SO; SO So; So.init(ntl, F.G, (int)blockIdx.x, wsp<int>(F, WS_TILES) + 257);
                    pg8::EpiPlain E{wsp<bf16_t>(F, WS_YP), D, 1.0f / (SA8 * SWD8)};
                    pg8::gemm_phase<DFF / 2, pg8::EpiPlain, SO, true, MK_ALIGN8>(F.lds, g, So, E, F.wave); }
                } } SEAM(pb + 7);
    }
    if (IN(17)) { frame_tid(F); if (MK_DUP & 2) row_phase<4>(F, 1, true); row_phase<4>(F, 1); }
#undef IN
#undef SEAM
}

extern "C" void kernel_launch(void* const* d_in, const int* in_sizes, int n_in, void* d_out, int out_size, void* d_ws, size_t ws_size, hipStream_t stream) {
    static int grid = 0;
    if (grid == 0) {
        if (n_in != 20 || in_sizes[0] != S * D || out_size != S * D || ws_size < WS_END) { fprintf(stderr, "kernel_launch: shape/workspace mismatch (n_in %d, in0 %d, out %d, ws %zu < %zu)\n", n_in, n_in > 0 ? in_sizes[0] : -1, out_size, ws_size, (size_t)WS_END); grid = -1; return; }
        int dev = 0, cus = 0;
        if (hipGetDevice(&dev) != hipSuccess || hipDeviceGetAttribute(&cus, hipDeviceAttributeMultiprocessorCount, dev) != hipSuccess) { grid = -1; return; }
        if (hipFuncSetAttribute((const void*)fwd, hipFuncAttributeMaxDynamicSharedMemorySize, LDS_BYTES) != hipSuccess) { fprintf(stderr, "kernel_launch: hipFuncSetAttribute failed\n"); grid = -1; return; }
        int per_cu = 0;
        if (hipOccupancyMaxActiveBlocksPerMultiprocessor(&per_cu, (const void*)fwd, 512, LDS_BYTES) != hipSuccess || per_cu < 1) fprintf(stderr, "kernel_launch: occupancy query says %d\n", per_cu);
        (void)hipGetLastError();
        grid = cus;
    }
    if (grid < 0) return;
    (void)hipMemsetAsync((char*)d_ws + WS_CTL, 0, CTL_ZERO_BYTES, stream);
    Args a{};
    for (int i = 0; i < 20; ++i) a.in[i] = d_in[i];
    a.out = (float*)d_out; a.ws = (unsigned char*)d_ws;
#if MK_PER_PHASE
    for (int p = 0; p < NPHASE; ++p) { if (p == 6) continue; a.ph_lo = p; a.ph_hi = p + 1; hipLaunchKernelGGL(fwd, dim3(grid), dim3(512), LDS_BYTES, stream, a); }
#else
    a.ph_lo = 0; a.ph_hi = NPHASE;
    hipLaunchKernelGGL(fwd, dim3(grid), dim3(512), LDS_BYTES, stream, a);
#endif
    const hipError_t le = hipPeekAtLastError();
    if (le != hipSuccess) fprintf(stderr, "kernel_launch: launch failed: %s\n", hipGetErrorName(le));
}
```
